# Optimizing an MI355X kernel written in HIP

```python
import jax, jax.numpy as jnp
from jax import lax
import numpy as np

D_MODEL = 1024
BATCH = 8
SEQ = 4096
DEPTH = 2

HEAD_DIM = 64
GROUP_WIDTH = D_MODEL // 4
GROUP_HEADS = GROUP_WIDTH // HEAD_DIM
MIX_WIDTH = 4 * GROUP_WIDTH
ROPE_THETA = 10000.0
Q_BLOCK = 128

MOBA_BLOCK = 256
MOBA_TOPK = 3
RET_CHUNK = 128
RG_CONV = 4
RG_C = 8.0
RG_BLOCKS = GROUP_HEADS
RG_BLOCK_W = GROUP_WIDTH // RG_BLOCKS
IDX_HEADS = 8
IDX_DIM = HEAD_DIM
IDX_SCALE = (IDX_HEADS ** -0.5) * (IDX_DIM ** -0.5)
DSA_TOPK = 256

N_EXPERTS = 32
TOP_K = 4
D_FF = D_MODEL
SWIGLU_LIMIT = 7.0
SWIGLU_ALPHA = 1.702

ALPHA = (2 * DEPTH) ** 0.25
BETA = (8 * DEPTH) ** -0.25
LN_EPS = 1e-5

IN_SIZES = (GROUP_WIDTH,) * 3 + (GROUP_WIDTH,) * 4 + (GROUP_WIDTH,) * 2 + (GROUP_WIDTH,) * 3 + (IDX_HEADS * IDX_DIM, IDX_DIM, IDX_HEADS)
IN_WIDTH = 12 * GROUP_WIDTH + IDX_HEADS * IDX_DIM + IDX_DIM + IDX_HEADS

kernel_name = 'hybrid_moba_retnet_rglru_dsa_moe'

F32 = jnp.float32


def _layer_norm(x, g, b):
    xf = x.astype(F32)
    mu = jnp.mean(xf, axis=-1, keepdims=True)
    var = jnp.mean(jnp.square(xf - mu), axis=-1, keepdims=True)
    return ((xf - mu) * lax.rsqrt(var + LN_EPS) * g.astype(F32) + b.astype(F32)).astype(x.dtype)


def _rope_tables(T):
    inv = ROPE_THETA ** (-jnp.arange(0, HEAD_DIM, 2, dtype=F32) / HEAD_DIM)
    ang = jnp.arange(T, dtype=F32)[:, None] * inv[None, :]
    return jnp.cos(ang), jnp.sin(ang)


def _rope(x, cos, sin):
    xf = x.astype(F32)
    x1, x2 = jnp.split(xf, 2, axis=-1)
    c = cos[None, :, None, :]
    s = sin[None, :, None, :]
    return jnp.concatenate([x1 * c - x2 * s, x2 * c + x1 * s], axis=-1).astype(x.dtype)


def _moba_attention(q, k, v):
    B, T, H, d = q.shape
    nB = -(-T // MOBA_BLOCK)
    pad = nB * MOBA_BLOCK - T
    kp = jnp.pad(k, ((0, 0), (0, pad), (0, 0), (0, 0)))
    vp = jnp.pad(v, ((0, 0), (0, pad), (0, 0), (0, 0)))
    kb = kp.reshape(B, nB, MOBA_BLOCK, H, d).transpose(0, 3, 1, 2, 4)
    vb = vp.reshape(B, nB, MOBA_BLOCK, H, d).transpose(0, 3, 1, 2, 4)
    kmean = jnp.mean(kb.astype(F32), axis=3).astype(q.dtype)
    kt = min(MOBA_TOPK, nB)
    nQ = T // Q_BLOCK
    qc = q.reshape(B, nQ, Q_BLOCK, H, d)
    scale = d ** -0.5
    h_idx = jnp.arange(H)[None, :, None]

    def per_seq(args):
        qs, kps, vps, kbs, vbs, kms = args

        def per_chunk(cargs):
            qq, j = cargs
            start = j * Q_BLOCK
            own = start // MOBA_BLOCK
            pos_q = start + jnp.arange(Q_BLOCK)
            gate = jnp.einsum('qhd,hnd->qhn', qq, kms).astype(F32)
            gate = jnp.where(jnp.arange(nB) < own, gate, -jnp.inf)
            _, sel = lax.top_k(gate, kt)
            valid = sel < own
            kg = kbs[h_idx, sel]
            vg = vbs[h_idx, sel]
            s_sel = jnp.einsum('qhd,qhnkd->qhnk', qq, kg).astype(F32) * scale
            s_sel = jnp.where(valid[..., None], s_sel, -jnp.inf).reshape(Q_BLOCK, H, kt * MOBA_BLOCK)
            k_own = lax.dynamic_slice_in_dim(kps, own * MOBA_BLOCK, MOBA_BLOCK, axis=0)
            v_own = lax.dynamic_slice_in_dim(vps, own * MOBA_BLOCK, MOBA_BLOCK, axis=0)
            pos_k = own * MOBA_BLOCK + jnp.arange(MOBA_BLOCK)
            s_own = jnp.einsum('qhd,khd->qhk', qq, k_own).astype(F32) * scale
            s_own = jnp.where((pos_k[None, :] <= pos_q[:, None])[:, None, :], s_own, -jnp.inf)
            p = jax.nn.softmax(jnp.concatenate([s_sel, s_own], axis=-1), axis=-1).astype(vg.dtype)
            p_sel = p[..., :kt * MOBA_BLOCK].reshape(Q_BLOCK, H, kt, MOBA_BLOCK)
            p_own = p[..., kt * MOBA_BLOCK:]
            return jnp.einsum('qhnk,qhnkd->qhd', p_sel, vg) + jnp.einsum('qhk,khd->qhd', p_own, v_own)

        return lax.map(per_chunk, (qs, jnp.arange(nQ)))

    out = lax.map(per_seq, (qc, kp, vp, kb, vb, kmean))
    return out.reshape(B, T, H, d)


def _retention(q, k, v):
    B, T, H, d = q.shape
    dv = v.shape[-1]
    C = RET_CHUNK
    N = T // C
    log_g = jnp.log(1.0 - 2.0 ** (-5.0 - jnp.arange(H, dtype=F32)))
    n = jnp.arange(C, dtype=F32)
    diff = n[:, None] - n[None, :]
    d_mask = jnp.where(diff >= 0, jnp.exp(log_g[:, None, None] * jnp.maximum(diff, 0.0)), 0.0)
    xi = jnp.exp(log_g[:, None] * (n + 1.0))[None, :, :, None]
    zeta = jnp.exp(log_g[:, None] * (C - 1.0 - n))[None, :, :, None]
    g_chunk = jnp.exp(log_g * C)[None, :, None, None]
    to_chunks = lambda t: t.reshape(B, N, C, H, t.shape[-1]).transpose(1, 0, 3, 2, 4)

    def step(R, inp):
        qc, kc, vc = inp
        inner = jnp.einsum('bhnd,bhmd->bhnm', qc, kc) * d_mask
        o = jnp.einsum('bhnm,bhme->bhne', inner, vc) + jnp.einsum('bhnd,bhde->bhne', qc, R) * xi
        R = jnp.einsum('bhmd,bhme->bhde', kc * zeta, vc) + g_chunk * R
        return R, o

    R0 = jnp.zeros((B, H, d, dv), F32)
    _, o = lax.scan(step, R0, (to_chunks(q), to_chunks(k), to_chunks(v)))
    return o.transpose(1, 0, 3, 2, 4).reshape(B, T, H, dv)


def _rg_lru(xr, xg, conv_w, conv_b, wx, bx, wa, ba, lam):
    B, T, C = xr.shape
    xc = lax.conv_general_dilated(xr, conv_w[:, None, :], window_strides=(1,), padding=[(RG_CONV - 1, 0)],
                                  dimension_numbers=('NWC', 'WIO', 'NWC'), feature_group_count=C) + conv_b
    xb = xc.reshape(B, T, RG_BLOCKS, RG_BLOCK_W)
    gate_x = jax.nn.sigmoid((jnp.einsum('btnc,ncd->btnd', xb, wx).reshape(B, T, C) + bx).astype(F32))
    gate_a = jax.nn.sigmoid((jnp.einsum('btnc,ncd->btnd', xb, wa).reshape(B, T, C) + ba).astype(F32))
    log_a = -RG_C * gate_a * jax.nn.softplus(-lam.astype(F32))
    a = jnp.exp(log_a)
    b = jnp.sqrt(-jnp.expm1(2.0 * log_a)) * (gate_x * xc.astype(F32))

    def combine(left, right):
        a_l, b_l = left
        a_r, b_r = right
        return a_l * a_r, a_r * b_l + b_r

    _, h = lax.associative_scan(combine, (a, b), axis=1)
    return (h * jax.nn.gelu(xg.astype(F32))).astype(xr.dtype)


def _dsa_attention(q, k, v, qi, ki, wi):
    B, T, H, d = q.shape
    n_sel = min(DSA_TOPK, T // 4)
    nQ = T // Q_BLOCK
    scale = d ** -0.5
    qc = q.reshape(B, nQ, Q_BLOCK, H, d)
    qic = qi.reshape(B, nQ, Q_BLOCK, IDX_HEADS, IDX_DIM)
    wic = wi.reshape(B, nQ, Q_BLOCK, IDX_HEADS)
    pos_s = jnp.arange(T)

    def per_seq(args):
        qs, qis, wis, ks, vs, kis = args

        def per_chunk(cargs):
            qq, qiq, wq, j = cargs
            pos_q = j * Q_BLOCK + jnp.arange(Q_BLOCK)
            rel = jax.nn.relu(jnp.einsum('qhd,sd->qhs', qiq, kis).astype(F32))
            score = jnp.einsum('qh,qhs->qs', wq.astype(F32), rel) * IDX_SCALE
            score = jnp.where(pos_s[None, :] <= pos_q[:, None], score, -jnp.inf)
            _, idx = lax.top_k(score, n_sel)
            valid = idx <= pos_q[:, None]
            kg = ks[idx]
            vg = vs[idx]
            s = jnp.einsum('qhd,qkhd->qhk', qq, kg).astype(F32) * scale
            s = jnp.where(valid[:, None, :], s, -jnp.inf)
            p = jax.nn.softmax(s, axis=-1).astype(vg.dtype)
            return jnp.einsum('qhk,qkhd->qhd', p, vg)

        return lax.map(per_chunk, (qs, qis, wis, jnp.arange(nQ)))

    out = lax.map(per_seq, (qc, qic, wic, k, v, ki))
    return out.reshape(B, T, H, d)


def _moe(x, router_w, router_b, w1, b1, w2, b2):
    B, T, D = x.shape
    xf = x.reshape(B * T, D)
    logits = jnp.einsum('nd,de->ne', xf, router_w).astype(F32) + router_b.astype(F32)
    top_v, top_i = lax.top_k(logits, TOP_K)
    gates = jax.nn.softmax(top_v, axis=-1)
    comb = jnp.sum(jax.nn.one_hot(top_i, N_EXPERTS, dtype=F32) * gates[..., None], axis=1)

    def expert_step(acc, e):
        w1e, b1e, w2e, b2e, ce = e
        h = xf @ w1e + b1e
        glu_in = jnp.minimum(h[:, :D_FF], SWIGLU_LIMIT)
        up = jnp.clip(h[:, D_FF:], -SWIGLU_LIMIT, SWIGLU_LIMIT)
        glu = glu_in * jax.nn.sigmoid(SWIGLU_ALPHA * glu_in)
        y = ((up + 1.0) * glu) @ w2e + b2e
        return acc + ce[:, None] * y.astype(F32), None

    acc, _ = lax.scan(expert_step, jnp.zeros((B * T, D), F32), (w1, b1, w2, b2, comb.T))
    return acc.astype(x.dtype).reshape(B, T, D)


def _hybrid_layer(x, cos, sin, w_in, ret_gn_g, ret_gn_b, conv_w, conv_b, rg_wx, rg_bx, rg_wa, rg_ba,
                  rg_lambda, w_out, ln1_g, ln1_b, router_w, router_b, exp_w1, exp_b1, exp_w2, exp_b2,
                  ln2_g, ln2_b):
    B, T, _ = x.shape
    proj = jnp.einsum('btd,dp->btp', x, w_in)
    (a_q, a_k, a_v, r_q, r_k, r_v, r_g, c_x, c_g, d_q, d_k, d_v, d_qi, d_ki, d_w) = jnp.split(
        proj, np.cumsum(IN_SIZES)[:-1].tolist(), axis=-1)
    heads = lambda t: t.reshape(B, T, GROUP_HEADS, HEAD_DIM)

    o_a = _moba_attention(_rope(heads(a_q), cos, sin), _rope(heads(a_k), cos, sin), heads(a_v))

    rq = _rope(heads(r_q).astype(F32), cos, sin)
    rk = _rope(heads(r_k).astype(F32), cos, sin) * (HEAD_DIM ** -0.5)
    o_r = _retention(rq, rk, heads(r_v).astype(F32))
    o_r = _layer_norm(o_r, ret_gn_g.reshape(GROUP_HEADS, HEAD_DIM), ret_gn_b.reshape(GROUP_HEADS, HEAD_DIM))
    o_r = (o_r.reshape(B, T, GROUP_WIDTH) * jax.nn.silu(r_g.astype(F32))).astype(x.dtype)

    o_c = _rg_lru(c_x, c_g, conv_w, conv_b, rg_wx, rg_bx, rg_wa, rg_ba, rg_lambda)

    qi = _rope(d_qi.reshape(B, T, IDX_HEADS, IDX_DIM), cos, sin)
    ki = _rope(d_ki.reshape(B, T, 1, IDX_DIM), cos, sin)[:, :, 0]
    o_d = _dsa_attention(_rope(heads(d_q), cos, sin), _rope(heads(d_k), cos, sin), heads(d_v), qi, ki, d_w)

    mixed = jnp.concatenate([o_a.reshape(B, T, GROUP_WIDTH), o_r, o_c, o_d.reshape(B, T, GROUP_WIDTH)], axis=-1)
    x = _layer_norm(ALPHA * x + jnp.einsum('btm,md->btd', mixed, w_out), ln1_g, ln1_b)
    x = _layer_norm(ALPHA * x + _moe(x, router_w, router_b, exp_w1, exp_b1, exp_w2, exp_b2), ln2_g, ln2_b)
    return x


def setup_inputs(seed: int = 0) -> dict:
    key = jax.random.key(seed)
    ks = jax.random.split(key, 24)
    nrm = lambda k, shape, s: jax.random.normal(k, shape, F32) * s
    u = jax.random.uniform(ks[9], (DEPTH, GROUP_WIDTH), F32, 0.9, 0.999)
    a0 = u ** (1.0 / RG_C)
    return {
        'x': jax.random.normal(ks[0], (BATCH, SEQ, D_MODEL), F32),
        'w_in': nrm(ks[1], (DEPTH, D_MODEL, IN_WIDTH), D_MODEL ** -0.5),
        'ret_gn_g': 1.0 + nrm(ks[2], (DEPTH, GROUP_WIDTH), 0.02),
        'ret_gn_b': nrm(ks[3], (DEPTH, GROUP_WIDTH), 0.02),
        'conv_w': nrm(ks[4], (DEPTH, RG_CONV, GROUP_WIDTH), RG_CONV ** -0.5),
        'conv_b': nrm(ks[5], (DEPTH, GROUP_WIDTH), 0.02),
        'rg_wx': nrm(ks[6], (DEPTH, RG_BLOCKS, RG_BLOCK_W, RG_BLOCK_W), RG_BLOCK_W ** -0.5),
        'rg_bx': nrm(ks[7], (DEPTH, GROUP_WIDTH), 0.02),
        'rg_wa': nrm(ks[8], (DEPTH, RG_BLOCKS, RG_BLOCK_W, RG_BLOCK_W), RG_BLOCK_W ** -0.5),
        'rg_ba': nrm(ks[10], (DEPTH, GROUP_WIDTH), 0.02),
        'rg_lambda': jnp.log(a0) - jnp.log1p(-a0),
        'w_out': nrm(ks[11], (DEPTH, MIX_WIDTH, D_MODEL), BETA * MIX_WIDTH ** -0.5),
        'ln1_g': 1.0 + nrm(ks[12], (DEPTH, D_MODEL), 0.02),
        'ln1_b': nrm(ks[13], (DEPTH, D_MODEL), 0.02),
        'router_w': nrm(ks[14], (DEPTH, D_MODEL, N_EXPERTS), D_MODEL ** -0.5),
        'router_b': nrm(ks[15], (DEPTH, N_EXPERTS), 0.01),
        'exp_w1': nrm(ks[16], (DEPTH, N_EXPERTS, D_MODEL, 2 * D_FF), D_MODEL ** -0.5),
        'exp_b1': nrm(ks[17], (DEPTH, N_EXPERTS, 2 * D_FF), 0.02),
        'exp_w2': nrm(ks[18], (DEPTH, N_EXPERTS, D_FF, D_MODEL), BETA * D_FF ** -0.5),
        'exp_b2': nrm(ks[19], (DEPTH, N_EXPERTS, D_MODEL), 0.02),
        'ln2_g': 1.0 + nrm(ks[20], (DEPTH, D_MODEL), 0.02),
        'ln2_b': nrm(ks[21], (DEPTH, D_MODEL), 0.02),
    }


def reference(x, w_in, ret_gn_g, ret_gn_b, conv_w, conv_b, rg_wx, rg_bx, rg_wa, rg_ba, rg_lambda, w_out,
              ln1_g, ln1_b, router_w, router_b, exp_w1, exp_b1, exp_w2, exp_b2, ln2_g, ln2_b):
    cos, sin = _rope_tables(x.shape[1])
    for l in range(DEPTH):
        x = _hybrid_layer(x, cos, sin, w_in[l], ret_gn_g[l], ret_gn_b[l], conv_w[l], conv_b[l], rg_wx[l],
                          rg_bx[l], rg_wa[l], rg_ba[l], rg_lambda[l], w_out[l], ln1_g[l], ln1_b[l],
                          router_w[l], router_b[l], exp_w1[l], exp_b1[l], exp_w2[l], exp_b2[l],
                          ln2_g[l], ln2_b[l])
    return x
```

```cpp
#include <hip/hip_runtime.h>
#include <cstdio>
#include <cstdint>

#ifndef ONE_LAUNCH
#define ONE_LAUNCH 1
#endif

namespace pg8 {
#define PG8_LAS __attribute__((address_space(3)))
typedef unsigned short bf16_t;
typedef short bf16x8 __attribute__((ext_vector_type(8)));
typedef float f32x4 __attribute__((ext_vector_type(4)));
typedef unsigned u32x4 __attribute__((ext_vector_type(4)));
constexpr int BM = 256, BK = 64, HALF = 128, HTB = HALF * BK * 2  , STAGE_BYTES = 8 * HTB, NXCD = 8, WGM = 8;

__host__ __device__ __forceinline__ int lds_byte(int r, int c) { const int st = (r >> 4) * 2 + (c >> 5), rr = r & 15, cc = c & 31, ob = rr * 64 + cc * 2; return st * 1024 + (ob ^ (((ob >> 9) & 1) << 5)); }
__host__ __device__ __forceinline__ void stage_rc(int b, int& R, int& C) { const int st = b / 1024, sb = b % 1024, swz = sb ^ (((sb >> 9) & 1) << 5); R = (st >> 1) * 16 + swz / 64; C = (st & 1) * 32 + (swz % 64) / 2; }
__host__ __device__ __forceinline__ int perm32(int rho) { const int n = rho >> 4, i = rho & 15; return 8 * (i >> 2) + 4 * n + (i & 3); }

struct Unit { int pm, pn; };

struct StaticOrder {
    static constexpr bool GATHER = false;
    __device__ __forceinline__ unsigned rowoff(const Unit&, int) const { return 0u; }
    int nM, nN, nwg, G, c; const char* Ab; const char* Bb; size_t tstep;
    __device__ __forceinline__ void init(const void* A, const void* Bt, int M, int N, int K, int G_, int c_) { nM = M / BM; nN = N / BM; nwg = nM * nN; G = G_; c = c_; Ab = (const char*)A; Bb = (const char*)Bt; tstep = (size_t)BM * K * 2; }
    __device__ __forceinline__ bool next(int i, Unit& u) const {
        const long L = (long)i * G + c; if (L >= nwg) return false;
        int wgid = (int)L; { const int q = nwg / NXCD, r = nwg % NXCD, xcd = wgid % NXCD, off = wgid / NXCD; wgid = (xcd < r ? xcd * (q + 1) : r * (q + 1) + (xcd - r) * q) + off; }
        const int nig = WGM * nN, gid = wgid / nig, fm = gid * WGM, gsz = (nM - fm) < WGM ? (nM - fm) : WGM;
        u.pm = fm + ((wgid % nig) % gsz); u.pn = (wgid % nig) / gsz; return true;
    }
    __device__ __forceinline__ const char* A(const Unit& u) const { return Ab + (size_t)u.pm * tstep; }
    __device__ __forceinline__ const char* B(const Unit& u) const { return Bb + (size_t)u.pn * tstep; }
    __device__ __forceinline__ void a_ready(const Unit&) const {}
    __device__ __forceinline__ void done(const Unit&) const {}
    __device__ __forceinline__ int lag() const { return 0; }
};
struct MoeOrder {
    static constexpr bool GATHER = false;
    __device__ __forceinline__ unsigned rowoff(const Unit&, int) const { return 0u; }
    int nN, np, ppx, G, c; const char* Ab; const char* Wb; size_t tstep, estride; const PG8_LAS int* ptab;
    __device__ __forceinline__ void init(int nN_, int np_, int G_, int c_) { nN = nN_; np = np_; G = G_; c = c_; ppx = (np_ + NXCD - 1) / NXCD; }
    __device__ __forceinline__ bool next(int i, Unit& u) const {
        if (G % NXCD != 0) { const long L = (long)i * G + c; if (L >= (long)np * nN) return false; u.pm = (int)L / nN; u.pn = (int)L % nN; return true; }
        const int x = c % NXCD, s = c / NXCD, wpx = G / NXCD, v = i * wpx + s, pl = v / nN;
        const int p0 = x * ppx, pend = (p0 + ppx) < np ? (p0 + ppx) : np;
        if (p0 + pl >= pend) return false;
        u.pm = p0 + pl; u.pn = v % nN; return true;
    }
    __device__ __forceinline__ const char* A(const Unit& u) const { return Ab + (size_t)u.pm * tstep; }
    __device__ __forceinline__ const char* B(const Unit& u) const { const int e = __builtin_amdgcn_readfirstlane(ptab[u.pm]); return Wb + (size_t)e * estride + (size_t)u.pn * tstep; }
    __device__ __forceinline__ void a_ready(const Unit&) const {}
    __device__ __forceinline__ void done(const Unit&) const {}
    __device__ __forceinline__ int lag() const { return (G % NXCD != 0) ? (int)(((long)c * 32) / G) : (int)(((long)(c / NXCD) * 32) / (G / NXCD)); }
};

struct MoeGatherOrder : MoeOrder {
    static constexpr bool GATHER = true;
    const int* rowtok; const PG8_LAS int* off; const PG8_LAS int* cnt; unsigned rowbytes;
    __device__ __forceinline__ const char* A(const Unit&) const { return Ab; }
    __device__ __forceinline__ unsigned rowoff(const Unit& u, int prow) const {
        const int e = __builtin_amdgcn_readfirstlane(ptab[u.pm]); const int valid = __builtin_amdgcn_readfirstlane(cnt[e] - (u.pm * 256 - off[e]));
        const int lrow = __builtin_amdgcn_readfirstlane(u.pm * 256 - off[e]);
        const int tok = (prow < valid) ? rowtok[(size_t)e * 32768 + lrow + prow] : 0;
        return (unsigned)tok * rowbytes;
    }
};

typedef int v8i_t __attribute__((ext_vector_type(8)));
template <class Epi, class Sched, bool ALIGN_EPI = false, bool SP2 = false, bool F8 = false, int STAGGER = 0>
__device__ __forceinline__ void gemm_phase(PG8_LAS unsigned char* lds, const int K, const Sched& S, const Epi& E) {
    int tid_ = threadIdx.x; asm volatile("" : "+v"(tid_)); const int tid = tid_, wid = __builtin_amdgcn_readfirstlane(tid >> 6), lane = tid & 63, wr = wid >> 2, wc = wid & 3, fr = lane & 15, fq = lane >> 4;
    const int nt = K / BK;
    unsigned voffA[2], voffB[2];
    constexpr bool GA = Sched::GATHER;
    int RpA[2]; unsigned CpA[2];
    unsigned cv0[2] = {0u, 0u}, cv1[2] = {0u, 0u}, nv0[2] = {0u, 0u}, nv1[2] = {0u, 0u};
#pragma unroll
    for (int i = 0; i < 2; ++i) { int R, C; stage_rc(tid * 16 + i * 8192, R, C); const int Rb = Epi::PERM ? ((R & ~31) + perm32(R & 31)) : R;
        voffA[i] = (unsigned)(R * K + C) * 2u; voffB[i] = (unsigned)(Rb * K + C) * 2u; RpA[i] = R; CpA[i] = (unsigned)C * 2u; }
    const size_t kstep = (size_t)(BK * 2);
    const size_t hstep = (size_t)HALF * K * 2;
    const unsigned ldsw = (unsigned)wid * 1024u;
    const int aoff = F8 ? lds_byte(wr * 64 + fr, (fq & 1) * 16) + (fq >> 1) * 1024 : lds_byte(wr * 64 + fr, fq * 8);
    const int boff = F8 ? lds_byte(wc * 32 + fr, (fq & 1) * 16) + (fq >> 1) * 1024 : lds_byte(wc * 32 + fr, fq * 8);
    int f8sc = 0x7f7f7f7f; (void)f8sc;
#define PG8_SA(b, h) (((b) * 2 + (h)) * HTB)
#define PG8_SB(b, h) ((4 + (b) * 2 + (h)) * HTB)
#define PG8_STAGE(bufoff, gbase, voff) do { _Pragma("unroll") for (int _i = 0; _i < 2; ++_i) \
        __builtin_amdgcn_global_load_lds((const unsigned*)((const char*)(gbase) + (voff)[_i]), (PG8_LAS unsigned*)(lds + (bufoff) + ldsw + _i * 8192), 16, 0, 0); } while (0)
#define PG8_STA(bufoff, base, half, V0, V1) do { if constexpr (GA) { if (half) PG8_STAGE(bufoff, base, V1); else PG8_STAGE(bufoff, base, V0); } else { PG8_STAGE(bufoff, (base) + ((half) ? hstep : 0), voffA); } } while (0)
#define PG8_GAOFF(u, D0, D1) do { _Pragma("unroll") for (int _i = 0; _i < 2; ++_i) { D0[_i] = S.rowoff(u, RpA[_i]) + CpA[_i]; D1[_i] = S.rowoff(u, HALF + RpA[_i]) + CpA[_i]; } } while (0)
#define PG8_LDA(dst, b, h) do { if constexpr (F8) { _Pragma("unroll") for (int m = 0; m < 4; ++m) dst##8[m] = *(const PG8_LAS v8i_t*)(lds + PG8_SA(b, h) + aoff + m * 2048); } else { _Pragma("unroll") for (int m = 0; m < 4; ++m) _Pragma("unroll") for (int k = 0; k < 2; ++k) dst[m][k] = *(const PG8_LAS bf16x8*)(lds + PG8_SA(b, h) + aoff + m * 2048 + k * 1024); } } while (0)
#define PG8_LDB(dst, b, h) do { if constexpr (F8) { _Pragma("unroll") for (int n = 0; n < 2; ++n) dst##8[n] = *(const PG8_LAS v8i_t*)(lds + PG8_SB(b, h) + boff + n * 2048); } else { _Pragma("unroll") for (int n = 0; n < 2; ++n) _Pragma("unroll") for (int k = 0; k < 2; ++k) dst[n][k] = *(const PG8_LAS bf16x8*)(lds + PG8_SB(b, h) + boff + n * 2048 + k * 1024); } } while (0)
#define PG8_MMA(ai, bj, At, Bt) do { __builtin_amdgcn_s_setprio(1); if constexpr (F8) { _Pragma("unroll") for (int m = 0; m < 4; ++m) _Pragma("unroll") for (int n = 0; n < 2; ++n) \
        asm volatile("v_mfma_scale_f32_16x16x128_f8f6f4 %0, %1, %2, %0, %3, %3 op_sel_hi:[0,0,0]" : "+v"(acc[ai][bj][m][n]) : "v"(Bt##8[n]), "v"(At##8[m]), "v"(f8sc)); } \
        else { _Pragma("unroll") for (int m = 0; m < 4; ++m) _Pragma("unroll") for (int n = 0; n < 2; ++n) _Pragma("unroll") for (int k = 0; k < 2; ++k) \
        acc[ai][bj][m][n] = __builtin_amdgcn_mfma_f32_16x16x32_bf16(Bt[n][k], At[m][k], acc[ai][bj][m][n], 0, 0, 0); } __builtin_amdgcn_s_setprio(0); } while (0)
#define PG8_WAIT_V(n) asm volatile("s_waitcnt vmcnt(" #n ")" ::: "memory")
#define PG8_WAIT_L(n) asm volatile("s_waitcnt lgkmcnt(" #n ")" ::: "memory")
#define PG8_BAR __builtin_amdgcn_s_barrier()
#define PG8_SCHED __builtin_amdgcn_sched_barrier(0)
    Unit cur, nxt; int ui = 0;
    if (!S.next(0, cur)) return;
    if constexpr (STAGGER > 0) { const int lg_ = __builtin_amdgcn_readfirstlane(S.lag()); for (int q = 0; q < lg_; ++q) __builtin_amdgcn_s_sleep(STAGGER); }
    f32x4 acc[2][2][4][2];
#pragma unroll
    for (int a = 0; a < 2; ++a)
#pragma unroll
        for (int b = 0; b < 2; ++b)
#pragma unroll
            for (int m = 0; m < 4; ++m)
#pragma unroll
                for (int n = 0; n < 2; ++n) acc[a][b][m][n] = (f32x4){0.f, 0.f, 0.f, 0.f};
    if constexpr (F8) { PG8_SCHED; asm volatile("s_nop 7" ::: "memory"); PG8_SCHED; }
    bf16x8 At[4][2], B0[2][2], B1[2][2];
    v8i_t At8[4], B08[2], B18[2];
    const char* cA = S.A(cur); const char* cB = S.B(cur);
    if constexpr (GA) PG8_GAOFF(cur, cv0, cv1);
    S.a_ready(cur);
    if constexpr (SP2) {
        PG8_STAGE(PG8_SB(0, 0), cB, voffB); PG8_STAGE(PG8_SB(0, 1), cB + hstep, voffB); PG8_STA(PG8_SA(0, 0), cA, 0, cv0, cv1); PG8_STA(PG8_SA(0, 1), cA, 1, cv0, cv1);
        if (wr == 1) PG8_BAR;
        PG8_WAIT_V(2); PG8_BAR;
        PG8_STAGE(PG8_SB(1, 0), cB + kstep, voffB); PG8_STA(PG8_SA(1, 0), cA + kstep, 0, cv0, cv1); PG8_STAGE(PG8_SB(1, 1), cB + hstep + kstep, voffB);
        PG8_WAIT_V(6); PG8_BAR;
    } else {
        PG8_STAGE(PG8_SB(0, 0), cB, voffB); PG8_STAGE(PG8_SA(0, 0), cA, voffA); PG8_STAGE(PG8_SB(0, 1), cB + hstep, voffB); PG8_STAGE(PG8_SA(0, 1), cA + hstep, voffA);
        if (wr == 1) PG8_BAR;
        PG8_WAIT_V(4); PG8_BAR;
        PG8_STAGE(PG8_SB(1, 0), cB + kstep, voffB); PG8_STAGE(PG8_SA(1, 0), cA + kstep, voffA); PG8_STAGE(PG8_SB(1, 1), cB + hstep + kstep, voffB);
        PG8_WAIT_V(6); PG8_BAR;
    }
    for (;;) {
        const bool has_next = S.next(ui + 1, nxt);
        const char* nA = has_next ? S.A(nxt) : cA; const char* nB = has_next ? S.B(nxt) : cB;
        if constexpr (GA) { if (has_next) PG8_GAOFF(nxt, nv0, nv1); else { nv0[0] = cv0[0]; nv0[1] = cv0[1]; nv1[0] = cv1[0]; nv1[1] = cv1[1]; } }
#pragma unroll 1
        for (int t = 0; t < nt; t += 2) {
            const bool last = (t == nt - 2);
            const char* a1 = cA + (size_t)(t + 1) * kstep;
            const char* a2 = last ? nA : cA + (size_t)(t + 2) * kstep; const char* b2 = last ? nB : cB + (size_t)(t + 2) * kstep;
            const char* a3 = a2 + kstep; const char* b3 = b2 + kstep;
            if (last && has_next) S.a_ready(nxt);
            unsigned sv0[2] = {0u, 0u}, sv1[2] = {0u, 0u};
            if constexpr (GA) { sv0[0] = last ? nv0[0] : cv0[0]; sv0[1] = last ? nv0[1] : cv0[1]; sv1[0] = last ? nv1[0] : cv1[0]; sv1[1] = last ? nv1[1] : cv1[1]; }
            if constexpr (SP2) {
            PG8_LDB(B0, 0, 0); PG8_LDB(B1, 0, 1); PG8_SCHED; PG8_LDA(At, 0, 0); PG8_STA(PG8_SA(1, 1), a1, 1, cv0, cv1);
            PG8_WAIT_V(8); PG8_WAIT_L(0); PG8_BAR; PG8_MMA(0, 0, At, B0); PG8_MMA(0, 1, At, B1); PG8_BAR; PG8_SCHED;
            PG8_LDA(At, 0, 1); PG8_STAGE(PG8_SB(0, 0), b2, voffB); PG8_STAGE(PG8_SB(0, 1), b2 + hstep, voffB); PG8_STA(PG8_SA(0, 0), a2, 0, sv0, sv1);
            PG8_WAIT_V(8); PG8_WAIT_L(0); PG8_BAR; PG8_MMA(1, 0, At, B0); PG8_MMA(1, 1, At, B1); PG8_BAR; PG8_SCHED;
            PG8_LDB(B0, 1, 0); PG8_LDB(B1, 1, 1); PG8_SCHED; PG8_LDA(At, 1, 0); PG8_STA(PG8_SA(0, 1), a2, 1, sv0, sv1);
            PG8_WAIT_V(8); PG8_WAIT_L(0); PG8_BAR; PG8_MMA(0, 0, At, B0); PG8_MMA(0, 1, At, B1); PG8_BAR; PG8_SCHED;
            PG8_LDA(At, 1, 1); PG8_STAGE(PG8_SB(1, 0), b3, voffB); PG8_STAGE(PG8_SB(1, 1), b3 + hstep, voffB); PG8_STA(PG8_SA(1, 0), a3, 0, sv0, sv1);
            PG8_WAIT_V(8); PG8_WAIT_L(0); PG8_BAR; PG8_MMA(1, 0, At, B0); PG8_MMA(1, 1, At, B1); PG8_BAR; PG8_SCHED;
            } else {
            PG8_LDB(B0, 0, 0); PG8_SCHED; PG8_LDA(At, 0, 0); PG8_STAGE(PG8_SA(1, 1), a1 + hstep, voffA);
            PG8_WAIT_L(8); PG8_BAR; PG8_WAIT_L(0); PG8_MMA(0, 0, At, B0); PG8_BAR; PG8_SCHED;
            PG8_LDB(B1, 0, 1); PG8_STAGE(PG8_SB(0, 0), b2, voffB);
            PG8_BAR; PG8_WAIT_L(0); PG8_MMA(0, 1, At, B1); PG8_BAR;
            PG8_LDA(At, 0, 1); PG8_STAGE(PG8_SA(0, 0), a2, voffA);
            PG8_BAR; PG8_WAIT_L(0); PG8_MMA(1, 0, At, B0); PG8_BAR; PG8_SCHED;
            PG8_STAGE(PG8_SB(0, 1), b2 + hstep, voffB);
            PG8_WAIT_V(6); PG8_BAR; PG8_MMA(1, 1, At, B1); PG8_BAR;
            PG8_LDB(B0, 1, 0); PG8_SCHED; PG8_LDA(At, 1, 0); PG8_STAGE(PG8_SA(0, 1), a2 + hstep, voffA);
            PG8_WAIT_L(8); PG8_BAR; PG8_WAIT_L(0); PG8_MMA(0, 0, At, B0); PG8_BAR; PG8_SCHED;
            PG8_LDB(B1, 1, 1); PG8_STAGE(PG8_SB(1, 0), b3, voffB);
            PG8_BAR; PG8_WAIT_L(0); PG8_MMA(0, 1, At, B1); PG8_BAR;
            PG8_LDA(At, 1, 1); PG8_STAGE(PG8_SA(1, 0), a3, voffA);
            PG8_BAR; PG8_WAIT_L(0); PG8_MMA(1, 0, At, B0); PG8_BAR; PG8_SCHED;
            PG8_STAGE(PG8_SB(1, 1), b3 + hstep, voffB);
            PG8_WAIT_V(6); PG8_BAR; PG8_MMA(1, 1, At, B1); PG8_BAR;
            }
        }
        if constexpr (F8) { PG8_SCHED; asm volatile("s_nop 15\n\ts_nop 15" ::: "memory"); PG8_SCHED; }
        if constexpr (ALIGN_EPI) { if (wr == 0) PG8_BAR; }
        if constexpr (!Epi::AFTER_DRAIN) { E(acc, cur, wr, wc, fr, fq); S.done(cur); }
        if (!has_next) break;
#pragma unroll
        for (int a = 0; a < 2; ++a)
#pragma unroll
            for (int b = 0; b < 2; ++b)
#pragma unroll
                for (int m = 0; m < 4; ++m)
#pragma unroll
                    for (int n = 0; n < 2; ++n) acc[a][b][m][n] = (f32x4){0.f, 0.f, 0.f, 0.f};
        if constexpr (F8) { PG8_SCHED; asm volatile("s_nop 7" ::: "memory"); PG8_SCHED; }
        cur = nxt; cA = nA; cB = nB; ++ui;
        if constexpr (GA) { cv0[0] = nv0[0]; cv0[1] = nv0[1]; cv1[0] = nv1[0]; cv1[1] = nv1[1]; }
        if constexpr (ALIGN_EPI) { if (wr == 1) PG8_BAR; }
    }
    PG8_WAIT_V(0);
    if constexpr (!ALIGN_EPI) { if (wr == 0) PG8_BAR; }
    PG8_BAR;
    if constexpr (Epi::AFTER_DRAIN) { E.fused(acc, cur, wr, wc, fr, fq, lds, wid, lane); S.done(cur); }
#undef PG8_SA
#undef PG8_SB
#undef PG8_STAGE
#undef PG8_STA
#undef PG8_GAOFF
#undef PG8_LDA
#undef PG8_LDB
#undef PG8_MMA
#undef PG8_WAIT_V
#undef PG8_WAIT_L
#undef PG8_BAR
#undef PG8_SCHED
}
}

constexpr int NWAVES = 8, NTHR = 512;
constexpr int NB = 8, T = 4096, D = 1024, M = NB * T, DEPTH = 2;
constexpr int INW = 3656, NP = 3840;
constexpr int NE = 32, FF = 1024;
constexpr float LN_EPS = 1e-5f, ALPHA_RES = 1.41421356237f;
constexpr int C_AQ = 0, C_AK = 256, C_AV = 512, C_RQ = 768, C_RK = 1024, C_RV = 1280, C_RG = 1536, C_CX = 1792, C_CG = 2048, C_DQ = 2304, C_DK = 2560, C_DV = 2816, C_QI = 3072, C_KI = 3584, C_W = 3648;
constexpr int MAXPANELS = 544;
constexpr int MAXROWS = MAXPANELS * 256;

constexpr size_t MiB = 1u << 20;
constexpr size_t WS_CTL = 0, CTL_ZERO_BYTES = 1 * MiB;
constexpr size_t WS_WIN = 1 * MiB;
constexpr size_t WS_WOUT = WS_WIN + 15 * MiB;
constexpr size_t WS_W1 = WS_WOUT + 4 * MiB;
constexpr size_t WS_W2 = WS_W1 + 256 * MiB;
constexpr size_t WS_ROPE = WS_W2 + 128 * MiB;
constexpr size_t WS_XB = WS_ROPE + 1 * MiB;
constexpr size_t WS_XF = WS_XB + 64 * MiB;
constexpr size_t WS_Y1 = WS_XF + 128 * MiB;
constexpr size_t WS_X1B = WS_Y1 + 128 * MiB;
constexpr size_t WS_MIX = WS_X1B + 64 * MiB;
constexpr size_t WS_PJ = WS_MIX + 64 * MiB;
constexpr size_t WS_SC = WS_PJ + 272 * MiB;
constexpr size_t WS_XP = WS_SC, WS_G = WS_SC + 272 * MiB;
constexpr size_t WS_ROWTOK = WS_XP;
constexpr size_t WS_X1Q = WS_XP + 8 * MiB;
constexpr int RT2_CAP = 32768;
constexpr size_t WS_MASK = WS_SC + 544 * MiB;
constexpr size_t WS_HLOC = WS_MASK + 16 * MiB;
constexpr size_t WS_PC = WS_HLOC + 32 * MiB;
constexpr size_t WS_RGS = WS_PC + 32 * MiB;
constexpr size_t WS_ST = WS_RGS + 2 * MiB;
constexpr size_t WS_RT = WS_ST + 16 * MiB;
constexpr size_t WS_KMB = WS_RT + 8 * MiB;
constexpr size_t WS_KN2 = WS_KMB + 256 * 1024;
constexpr size_t WS_RWB = WS_KMB + 512 * 1024;
constexpr size_t WS_RGW = WS_KMB + 768 * 1024;
constexpr size_t WS_TOK = WS_KMB + 1 * MiB;
constexpr size_t WS_END = WS_TOK + 2 * MiB;
static_assert(WS_END <= (size_t)2048 * MiB, "d_ws map exceeds 2 GiB");
constexpr int CW_BAR = 4096;
constexpr int CW_CNT = 16384;

constexpr int RING_BYTES = 131072;
constexpr int LDSCTL_OFF = RING_BYTES;
constexpr int LC_MISC = 0;
constexpr int LC_OFF = 256;
constexpr int LC_CNT = 2816;
constexpr int LC_PTAB = 512;
constexpr int LC_WCNT = 3072;
constexpr int LC_HIST = 4096;
constexpr int LC_REC = 4096;
constexpr int LDS_BYTES = 147456;

#define GAS __attribute__((address_space(1)))
#define LAS __attribute__((address_space(3)))
typedef unsigned short bf16;
typedef unsigned v4u __attribute__((ext_vector_type(4)));
typedef unsigned v2u __attribute__((ext_vector_type(2)));
typedef float f32x4 __attribute__((ext_vector_type(4)));
typedef float f32x2 __attribute__((ext_vector_type(2)));
typedef float f32x16 __attribute__((ext_vector_type(16)));
typedef short bf16x8 __attribute__((ext_vector_type(8)));
typedef GAS unsigned gu32;
#define RLX_AGENT __ATOMIC_RELAXED, __HIP_MEMORY_SCOPE_AGENT
#define LDS_WAIT() asm volatile("s_waitcnt lgkmcnt(0)" ::: "memory")
#define VM_WAIT() asm volatile("s_waitcnt vmcnt(0)" ::: "memory")
__device__ __forceinline__ float bf2f(bf16 b) { return __uint_as_float((unsigned)b << 16); }
__device__ __forceinline__ float bflo(unsigned w) { return __uint_as_float(w << 16); }
__device__ __forceinline__ float bfhi(unsigned w) { return __uint_as_float(w & 0xffff0000u); }
typedef float f32x2_cv __attribute__((ext_vector_type(2)));
typedef __bf16 bf16x2_cv __attribute__((ext_vector_type(2)));
__device__ __forceinline__ unsigned pk2(float lo, float hi) { const f32x2_cv v = {lo, hi}; const bf16x2_cv b = __builtin_convertvector(v, bf16x2_cv); return __builtin_bit_cast(unsigned, b); }
__device__ __forceinline__ float wave_sum(float v) {
#pragma unroll
    for (int o = 1; o < 64; o <<= 1) v += __shfl_xor(v, o);
    return v;
}
__device__ __forceinline__ int wave_sum_i(int v) {
#pragma unroll
    for (int o = 1; o < 64; o <<= 1) v += __shfl_xor(v, o);
    return v;
}
__device__ __forceinline__ int wave_prefix_incl(int x) {
    x += __builtin_amdgcn_update_dpp(0, x, 0x111, 0xf, 0xf, true);
    x += __builtin_amdgcn_update_dpp(0, x, 0x112, 0xf, 0xf, true);
    x += __builtin_amdgcn_update_dpp(0, x, 0x114, 0xf, 0xf, true);
    x += __builtin_amdgcn_update_dpp(0, x, 0x118, 0xf, 0xf, true);
    x += __builtin_amdgcn_update_dpp(0, x, 0x142, 0xa, 0xf, false);
    x += __builtin_amdgcn_update_dpp(0, x, 0x143, 0xc, 0xf, false);
    return x;
}
constexpr float SC_X8 = 16.0f, SC_W8 = 2048.0f, SC_G8 = 4.0f;
__device__ __forceinline__ float sat8(float x) { return fminf(fmaxf(x, -448.0f), 448.0f); }
__device__ __forceinline__ unsigned pk4_fp8(float a, float b, float c, float d) { int p = __builtin_amdgcn_cvt_pk_fp8_f32(sat8(a), sat8(b), 0, false); p = __builtin_amdgcn_cvt_pk_fp8_f32(sat8(c), sat8(d), p, true); return (unsigned)p; }
__device__ __forceinline__ f32x4 mfma16(bf16x8 a, bf16x8 b, f32x4 c) { return __builtin_amdgcn_mfma_f32_16x16x32_bf16(a, b, c, 0, 0, 0); }
__device__ __forceinline__ float sigmoidf_(float x) { return __builtin_amdgcn_rcpf(1.f + __builtin_amdgcn_exp2f(-1.4426950408889634f * x)); }
#define XB_TMO      128
#define XB_XCNT(j)  (256  + 64 * (j))
#define XB_XSUB(j)  (1280 + 64 * (j))
#define XB_XGEN(j)  (2304 + 64 * (j))
#define XB_TOP      3328
#define XB_TOPGEN   3392
#define XCD_BAR_WORDS 3456
#define XB_SPIN_CAP (1u << 18)

__device__ __forceinline__ unsigned xb_ld(unsigned* p)              { return __hip_atomic_load(p, __ATOMIC_RELAXED, __HIP_MEMORY_SCOPE_AGENT); }
__device__ __forceinline__ unsigned xb_add(unsigned* p, unsigned v) { return __hip_atomic_fetch_add(p, v, __ATOMIC_RELAXED, __HIP_MEMORY_SCOPE_AGENT); }
__device__ __forceinline__ unsigned xb_xcc_id() { return (unsigned)__builtin_amdgcn_s_getreg((3 << 11) | 20) & 0xFu; }
#define XB_SPIN(cond, bar) do { unsigned _sp = 0; while (cond) { __builtin_amdgcn_s_sleep(1); \
    if ((++_sp & 255u) == 0u) { if (xb_ld(&(bar)[XB_TMO])) break; if (_sp > XB_SPIN_CAP) { atomicAdd(&(bar)[XB_TMO], 1u); break; } } } } while (0)

struct XcdBarrier {
    unsigned* bar; unsigned x;
    volatile LAS unsigned* st;
};

__device__ __forceinline__ XcdBarrier xcd_barrier_post(unsigned* bar, volatile LAS unsigned* st) {
    XcdBarrier b; b.bar = bar; b.x = xb_xcc_id(); b.st = st;
    if (threadIdx.x == 0) (void)xb_add(&bar[XB_XCNT(b.x)], 1u);
    return b;
}
__device__ __forceinline__ void xcd_barrier_complete(unsigned* bar, unsigned x, unsigned& nloc, unsigned& nx) {
    const unsigned G = gridDim.x * gridDim.y * gridDim.z;
    unsigned sum, cnt, mine, sp = 0u;
    for (;;) {
        sum = 0u; cnt = 0u; mine = 0u;
#pragma unroll
        for (unsigned j = 0; j < 16; ++j) { const unsigned c = xb_ld(&bar[XB_XCNT(j)]); sum += c; cnt += (c > 0u) ? 1u : 0u; mine = (j == x) ? c : mine; }
        if (sum == G) break;
        __builtin_amdgcn_s_sleep(1);
        if ((++sp & 255u) == 0u) { if (xb_ld(&bar[XB_TMO])) break; if (sp > XB_SPIN_CAP) { atomicAdd(&bar[XB_TMO], 1u); break; } }
    }
    nloc = mine > 0u ? mine : 1u; nx = cnt > 0u ? cnt : 1u;
}

__device__ __forceinline__ void xcd_barrier(const XcdBarrier& b) {
    asm volatile("s_waitcnt vmcnt(0)" ::: "memory");
    __syncthreads();
    if (threadIdx.x == 0) {
        unsigned* bar = b.bar;
        __builtin_amdgcn_s_waitcnt(0);
        unsigned nloc = b.st[0], nx = b.st[1];
        if (nloc == 0u) { xcd_barrier_complete(bar, b.x, nloc, nx); b.st[0] = nloc; b.st[1] = nx; }
        const unsigned old = xb_add(&bar[XB_XSUB(b.x)], 1u);
        const unsigned gen = old / nloc;
        if (old + 1u == (gen + 1u) * nloc) {
            __builtin_amdgcn_fence(__ATOMIC_RELEASE, "agent");
            asm volatile("s_waitcnt vmcnt(0)" ::: "memory");
            const unsigned og = xb_add(&bar[XB_TOP], 1u);
            const unsigned tg = og / nx;
            if (og + 1u == (tg + 1u) * nx) xb_add(&bar[XB_TOPGEN], 1u);
            else XB_SPIN(xb_ld(&bar[XB_TOPGEN]) == tg, bar);
            __builtin_amdgcn_fence(__ATOMIC_ACQUIRE, "agent");
            xb_add(&bar[XB_XGEN(b.x)], 1u);
            asm volatile("s_waitcnt vmcnt(0)" ::: "memory");
        } else {
            XB_SPIN(xb_ld(&bar[XB_XGEN(b.x)]) == gen, bar);
            __builtin_amdgcn_fence(__ATOMIC_ACQUIRE, "agent");
            asm volatile("s_waitcnt vmcnt(0)" ::: "memory");
        }
    }
    __syncthreads();
}

struct Args { const float* in[22]; float* out; unsigned char* ws; int ph_lo, ph_hi; };
struct Frame {
    LAS unsigned char* lds;
    LAS unsigned char* lctl;
    gu32* ctl;
    unsigned char* ws;
    int G, bid, layer;
};
__device__ __forceinline__ int ltid() { int t = threadIdx.x; asm volatile("" : "+v"(t)); return t; }
__device__ __forceinline__ const void* launder_uniform(const void* p) {
    unsigned lo = (unsigned)(unsigned long long)p, hi = (unsigned)((unsigned long long)p >> 32);
    asm volatile("" : "+v"(lo), "+v"(hi));
    lo = __builtin_amdgcn_readfirstlane(lo); hi = __builtin_amdgcn_readfirstlane(hi);
    return (const void*)(const __attribute__((address_space(1))) char*)(((unsigned long long)hi << 32) | lo);
}
typedef const __attribute__((address_space(4))) Args* KArgs;
__device__ __forceinline__ KArgs launder_kargs() {
    const unsigned long long p = (unsigned long long)__builtin_amdgcn_kernarg_segment_ptr();
    unsigned lo = (unsigned)p, hi = (unsigned)(p >> 32);
    asm volatile("" : "+v"(lo), "+v"(hi));
    lo = __builtin_amdgcn_readfirstlane(lo); hi = __builtin_amdgcn_readfirstlane(hi);
    return (KArgs)(((unsigned long long)hi << 32) | lo);
}
__device__ __forceinline__ int launder_i(int x) { asm volatile("" : "+v"(x)); return __builtin_amdgcn_readfirstlane(x); }
#define PH_PTRS unsigned char* wsl = (unsigned char*)launder_uniform(F.ws); KArgs Al = launder_kargs(); const int G_ = launder_i(F.G), bid_ = launder_i(F.bid); (void)Al; (void)G_; (void)bid_; (void)wsl
#define PH_IDS PH_PTRS; const int tid = ltid(), lane = tid & 63, w = __builtin_amdgcn_readfirstlane(tid >> 6); (void)lane; (void)w
#define LIN(i, stride) ((const float*)((const __attribute__((address_space(1))) float*)Al->in[i] + (size_t)F.layer * (stride)))
#define WSP(T_, off) ((T_*)(wsl + (off)))

struct EpiProj {
    static constexpr bool PERM = true, AFTER_DRAIN = false;
    bf16* O; const f32x2* cs;
#ifdef PROBE_EPI
    int skip;
#endif
    __device__ __forceinline__ void operator()(const pg8::f32x4 (&acc)[2][2][4][2], const pg8::Unit& u, int wr, int wc, int fr, int fq) const {
#ifdef PROBE_EPI
        if (skip) { if (acc[0][0][0][0][0] == 1.2345e-30f) O[0] = 0; return; }
#endif
        const int row0 = u.pm * 256 + wr * 64 + fr;
        const int colb = u.pn * 256 + wc * 32 + 8 * fq;
        const int i0 = (colb & 63) >> 1;
        const int colw = __builtin_amdgcn_readfirstlane(u.pn * 256 + wc * 32);
        bool ropeb[2]; float scb[2];
#pragma unroll
        for (int bj = 0; bj < 2; ++bj) { const int c0 = colw + bj * 128;
            ropeb[bj] = (c0 < 512) || (c0 >= 768 && c0 < 1280) || (c0 >= 2304 && c0 < 2816) || (c0 >= 3072 && c0 < 3648);
            scb[bj] = ((c0 < 256) || (c0 >= 2304 && c0 < 2560)) ? 0.18033688011112042f   : ((c0 >= 1024 && c0 < 1280) ? 0.125f : 1.0f); }
        f32x4 c01[2][4], c23[2][4];
        if (ropeb[0] || ropeb[1]) {
#pragma unroll
            for (int ai = 0; ai < 2; ++ai)
#pragma unroll
                for (int m = 0; m < 4; ++m) { const f32x4* cp = (const f32x4*)(cs + (size_t)((row0 + ai * 128 + m * 16) & (T - 1)) * 32 + i0); c01[ai][m] = cp[0]; c23[ai][m] = cp[1]; }
        }
#pragma unroll
        for (int bj = 0; bj < 2; ++bj) {
            const int col0 = colb + bj * 128;
            const float sc = scb[bj];
            if (ropeb[bj]) {
#pragma unroll
                for (int ai = 0; ai < 2; ++ai)
#pragma unroll
                    for (int m = 0; m < 4; ++m) {
                        const int row = row0 + ai * 128 + m * 16;
                        const pg8::f32x4 v0 = acc[ai][bj][m][0], v1 = acc[ai][bj][m][1];
                        const f32x4 ca = c01[ai][m] * sc, cb = c23[ai][m] * sc;
                        pg8::f32x4 o0, o1;
                        o0[0] = v0[0] * ca[0] - v0[1] * ca[1]; o0[1] = v0[1] * ca[0] + v0[0] * ca[1];
                        o0[2] = v0[2] * ca[2] - v0[3] * ca[3]; o0[3] = v0[3] * ca[2] + v0[2] * ca[3];
                        o1[0] = v1[0] * cb[0] - v1[1] * cb[1]; o1[1] = v1[1] * cb[0] + v1[0] * cb[1];
                        o1[2] = v1[2] * cb[2] - v1[3] * cb[3]; o1[3] = v1[3] * cb[2] + v1[2] * cb[3];
                        pg8::u32x4 w; w.x = pk2(o0[0], o0[1]); w.y = pk2(o0[2], o0[3]); w.z = pk2(o1[0], o1[1]); w.w = pk2(o1[2], o1[3]);
                        *(pg8::u32x4*)(O + (size_t)row * NP + col0) = w;
                    }
            } else {
#pragma unroll
                for (int ai = 0; ai < 2; ++ai)
#pragma unroll
                    for (int m = 0; m < 4; ++m) {
                        const int row = row0 + ai * 128 + m * 16;
                        const pg8::f32x4 v0 = acc[ai][bj][m][0] * sc, v1 = acc[ai][bj][m][1] * sc;
                        pg8::u32x4 w; w.x = pk2(v0[0], v0[1]); w.y = pk2(v0[2], v0[3]); w.z = pk2(v1[0], v1[1]); w.w = pk2(v1[2], v1[3]);
                        *(pg8::u32x4*)(O + (size_t)row * NP + col0) = w;
                    }
            }
        }
    }
};
struct EpiRes {
    static constexpr bool PERM = true, AFTER_DRAIN = false;
    const bf16* X; bf16* Y;
#ifdef PROBE_EPI
    int skip;
#endif
    __device__ __forceinline__ void operator()(const pg8::f32x4 (&acc)[2][2][4][2], const pg8::Unit& u, int wr, int wc, int fr, int fq) const {
#ifdef PROBE_EPI
        if (skip) { if (acc[0][0][0][0][0] == 1.2345e-30f) Y[0] = 0; return; }
#endif
        const int row0 = u.pm * 256 + wr * 64 + fr;
        const int colb = u.pn * 256 + wc * 32 + 8 * fq;
        v4u xh[2][4][2];
#pragma unroll
        for (int ai = 0; ai < 2; ++ai)
#pragma unroll
            for (int m = 0; m < 4; ++m)
#pragma unroll
                for (int bj = 0; bj < 2; ++bj) xh[ai][m][bj] = *(const v4u*)(X + (size_t)(row0 + ai * 128 + m * 16) * D + colb + bj * 128);
#pragma unroll
        for (int ai = 0; ai < 2; ++ai)
#pragma unroll
            for (int m = 0; m < 4; ++m)
#pragma unroll
                for (int bj = 0; bj < 2; ++bj) { bf16* yp = Y + (size_t)(row0 + ai * 128 + m * 16) * D + colb + bj * 128;
                    const v4u h = xh[ai][m][bj];
                    const f32x4 x0 = {bflo(h.x), bfhi(h.x), bflo(h.y), bfhi(h.y)}, x1 = {bflo(h.z), bfhi(h.z), bflo(h.w), bfhi(h.w)};
                    const f32x4 v0 = x0 * ALPHA_RES + acc[ai][bj][m][0], v1 = x1 * ALPHA_RES + acc[ai][bj][m][1];
                    pg8::u32x4 wv; wv.x = pk2(v0[0], v0[1]); wv.y = pk2(v0[2], v0[3]); wv.z = pk2(v1[0], v1[1]); wv.w = pk2(v1[2], v1[3]);
                    *(pg8::u32x4*)yp = wv; }
    }
};
struct EpiSwiglu {
    static constexpr bool PERM = true, AFTER_DRAIN = false;
    unsigned char* Gm; const float* b1; const LAS int* ptab;
#ifdef PROBE_EPI
    int skip;
#endif
    __device__ __forceinline__ void operator()(const pg8::f32x4 (&acc)[2][2][4][2], const pg8::Unit& u, int wr, int wc, int fr, int fq) const {
#ifdef PROBE_EPI
        if (skip) { if (acc[0][0][0][0][0] == 1.2345e-30f) Gm[0] = 0; return; }
#endif
        const int row0 = u.pm * 256 + wr * 64 + fr;
        const int e = __builtin_amdgcn_readfirstlane(ptab[u.pm]);
        const float* be = b1 + (size_t)e * 2048;
        const int j0 = u.pn * 128 + wc * 32 + 8 * fq;
        const f32x4 bg0 = *(const f32x4*)(be + j0), bg1 = *(const f32x4*)(be + j0 + 4), bu0 = *(const f32x4*)(be + 1024 + j0), bu1 = *(const f32x4*)(be + 1024 + j0 + 4);
        constexpr float DQ = 1.0f / (SC_X8 * SC_W8);
#pragma unroll
        for (int ai = 0; ai < 2; ++ai)
#pragma unroll
            for (int m = 0; m < 4; ++m) {
                const int row = row0 + ai * 128 + m * 16;
                float o[8];
#pragma unroll
                for (int n = 0; n < 2; ++n)
#pragma unroll
                    for (int k = 0; k < 4; ++k) {
                        const float hg = acc[ai][0][m][n][k] * DQ + (n ? bg1[k] : bg0[k]), hu = acc[ai][1][m][n][k] * DQ + (n ? bu1[k] : bu0[k]);
                        const float gi = fminf(hg, 7.0f), up = fminf(fmaxf(hu, -7.0f), 7.0f);
                        o[n * 4 + k] = (up + 1.0f) * gi * sigmoidf_(1.702f * gi) * SC_G8;
                    }
                v2u w; w.x = pk4_fp8(o[0], o[1], o[2], o[3]); w.y = pk4_fp8(o[4], o[5], o[6], o[7]);
                *(v2u*)(Gm + (size_t)row * FF + j0) = w;
            }
    }
};
struct EpiBias {
    static constexpr bool PERM = true, AFTER_DRAIN = false;
    bf16* Y; const float* b2; const LAS int* ptab;
#ifdef PROBE_EPI
    int skip; bf16* Y2;
#endif
    __device__ __forceinline__ void operator()(const pg8::f32x4 (&acc)[2][2][4][2], const pg8::Unit& u, int wr, int wc, int fr, int fq) const {
#ifdef PROBE_EPI
        if (skip && PROBE_EPI == 1) { if (acc[0][0][0][0][0] == 1.2345e-30f) Y[0] = 0; return; }
        if (skip) {
            const int row0 = u.pm * 256 + wr * 64 + fr;
            _Pragma("unroll") for (int bj = 0; bj < 2; ++bj) { const int col0 = u.pn * 256 + bj * 128 + wc * 32 + 8 * fq;
                _Pragma("unroll") for (int ai = 0; ai < 2; ++ai) _Pragma("unroll") for (int m = 0; m < 4; ++m) { const int row = (row0 + ai * 128 + m * 16) & 0xffff;
                    const pg8::f32x4 v0 = acc[ai][bj][m][0] * (1.0f / (SC_G8 * SC_W8)) + 0.5f, v1 = acc[ai][bj][m][1] * (1.0f / (SC_G8 * SC_W8)) + 0.25f;
                    pg8::u32x4 w; w.x = pk2(v0[0], v0[1]); w.y = pk2(v0[2], v0[3]); w.z = pk2(v1[0], v1[1]); w.w = pk2(v1[2], v1[3]);
                    *(pg8::u32x4*)(Y2 + (size_t)row * D + col0) = w; } }
            return; }
#endif
        const int row0 = u.pm * 256 + wr * 64 + fr;
        const int e = __builtin_amdgcn_readfirstlane(ptab[u.pm]);
        const float* be = b2 + (size_t)e * D;
        f32x4 bav[2], bbv[2];
#pragma unroll
        for (int bj = 0; bj < 2; ++bj) { const int col0 = u.pn * 256 + bj * 128 + wc * 32 + 8 * fq; bav[bj] = *(const f32x4*)(be + col0); bbv[bj] = *(const f32x4*)(be + col0 + 4); }
#pragma unroll
        for (int bj = 0; bj < 2; ++bj) {
            const int col0 = u.pn * 256 + bj * 128 + wc * 32 + 8 * fq;
            const f32x4 ba = bav[bj], bb = bbv[bj];
#pragma unroll
            for (int ai = 0; ai < 2; ++ai)
#pragma unroll
                for (int m = 0; m < 4; ++m) {
                    const int row = row0 + ai * 128 + m * 16;
                    const pg8::f32x4 v0 = acc[ai][bj][m][0] * (1.0f / (SC_G8 * SC_W8)) + ba, v1 = acc[ai][bj][m][1] * (1.0f / (SC_G8 * SC_W8)) + bb;
                    pg8::u32x4 w; w.x = pk2(v0[0], v0[1]); w.y = pk2(v0[2], v0[3]); w.z = pk2(v1[0], v1[1]); w.w = pk2(v1[2], v1[3]);
                    *(pg8::u32x4*)(Y + (size_t)row * D + col0) = w;
                }
        }
    }
};

template <int MAP> __device__ __forceinline__ int colmap(int c) {
    if (MAP == 1) {
        const bool rope = (c < 512) || (c >= 768 && c < 1280) || (c >= 2304 && c < 2816) || (c >= 3072 && c < 3648);
        if (rope) { const int d = c & 63; return (c & ~63) + 2 * (d & 31) + (d >> 5); }
        return c;
    }
    if (MAP == 2) { const int sgl = c >> 10, j = c & 1023; return (j >> 7) * 256 + sgl * 128 + (j & 127); }
    if (MAP == 3) return c;
    return c;
}
template <int MAP> __device__ __forceinline__ void transpose_item(const float* W, int K, int N, bf16* WT, LAS float* scr, int item, int lane) {
    const int nblk = (N + 31) / 32, kb = item / nblk, nb = item % nblk, k0 = 128 * kb, n0 = 32 * nb;
    const int col = n0 + (lane & 31);
    float v[64];
    const float* src = W + (size_t)(k0 + (lane >> 5)) * N + col;
#pragma unroll
    for (int i = 0; i < 64; ++i) v[i] = (col < N) ? src[(size_t)(2 * i) * N] : 0.f;
#pragma unroll
    for (int i = 0; i < 64; ++i) scr[(2 * i + (lane >> 5)) * 33 + (lane & 31)] = v[i];
    LDS_WAIT(); asm volatile("" ::: "memory");
    const int c = lane & 7;
#pragma unroll
    for (int j = 0; j < 4; ++j) { const int n = (lane >> 3) + 8 * j; const LAS float* s = scr + (16 * c) * 33 + n;
        if (MAP >= 2) {
            v4u o8; o8.x = pk4_fp8(s[0 * 33] * SC_W8, s[1 * 33] * SC_W8, s[2 * 33] * SC_W8, s[3 * 33] * SC_W8); o8.y = pk4_fp8(s[4 * 33] * SC_W8, s[5 * 33] * SC_W8, s[6 * 33] * SC_W8, s[7 * 33] * SC_W8);
            o8.z = pk4_fp8(s[8 * 33] * SC_W8, s[9 * 33] * SC_W8, s[10 * 33] * SC_W8, s[11 * 33] * SC_W8); o8.w = pk4_fp8(s[12 * 33] * SC_W8, s[13 * 33] * SC_W8, s[14 * 33] * SC_W8, s[15 * 33] * SC_W8);
            if (n0 + n < N) *(GAS v4u*)((GAS unsigned char*)WT + (size_t)colmap<MAP>(n0 + n) * K + k0 + 16 * c) = o8;
        } else {
        v4u o, p; o.x = pk2(s[0 * 33], s[1 * 33]); o.y = pk2(s[2 * 33], s[3 * 33]); o.z = pk2(s[4 * 33], s[5 * 33]); o.w = pk2(s[6 * 33], s[7 * 33]);
        p.x = pk2(s[8 * 33], s[9 * 33]); p.y = pk2(s[10 * 33], s[11 * 33]); p.z = pk2(s[12 * 33], s[13 * 33]); p.w = pk2(s[14 * 33], s[15 * 33]);
        if (n0 + n < N) { GAS v4u* dst = (GAS v4u*)(WT + (size_t)colmap<MAP>(n0 + n) * K + k0 + 16 * c); dst[0] = o; dst[1] = p; } } }
    LDS_WAIT(); asm volatile("" ::: "memory");
}
__device__ __forceinline__ void p0_prologue(Frame& F) {
    PH_IDS; const float* w_in = LIN(1, 0); const float* w_out = LIN(11, 0); const float* exp_w1 = LIN(16, 0); const float* exp_w2 = LIN(18, 0);
    LAS float* scr = (LAS float*)(F.lds + w * 16896);
    const int gw = bid_ * NWAVES + w, NGW = G_ * NWAVES;
    constexpr int I_IN = 8 * ((INW + 31) / 32), I_OUT = 8 * 32, I_1 = 8 * 64, I_2 = 8 * 32;
    constexpr int N_IN = DEPTH * I_IN, N_OUT = DEPTH * I_OUT, N_1 = DEPTH * NE * I_1, N_2 = DEPTH * NE * I_2;
    constexpr int NITEMS = N_IN + N_OUT + N_1 + N_2;
    for (int it = gw; it < NITEMS; it += NGW) {
        int r = it;
        if (r < N_IN) { const int l = r / I_IN; transpose_item<1>(w_in + (size_t)l * D * INW, D, INW, WSP(bf16, WS_WIN) + (size_t)l * NP * D, scr, r % I_IN, lane); continue; } r -= N_IN;
        if (r < N_OUT) { const int l = r / I_OUT; transpose_item<0>(w_out + (size_t)l * D * D, D, D, WSP(bf16, WS_WOUT) + (size_t)l * D * D, scr, r % I_OUT, lane); continue; } r -= N_OUT;
        if (r < N_1) { const int m = r / I_1; transpose_item<2>(exp_w1 + (size_t)m * D * 2048, D, 2048, (bf16*)(WSP(unsigned char, WS_W1) + (size_t)m * 2048 * D), scr, r % I_1, lane); continue; } r -= N_1;
        { const int m = r / I_2; transpose_item<3>(exp_w2 + (size_t)m * FF * D, FF, D, (bf16*)(WSP(unsigned char, WS_W2) + (size_t)m * D * FF), scr, r % I_2, lane); }
    }
    const int gt = bid_ * NTHR + tid, NGT = G_ * NTHR;
    for (int i = gt; i < DEPTH * (NP - INW) * (D / 8); i += NGT) { const int l = i / ((NP - INW) * (D / 8)), rr = i % ((NP - INW) * (D / 8));
        *(GAS v4u*)(WSP(bf16, WS_WIN) + (size_t)l * NP * D + (size_t)INW * D + (size_t)rr * 8) = (v4u){0u, 0u, 0u, 0u}; }
    for (int i = gt; i < T * 32; i += NGT) { const int t = i >> 5, k = i & 31;
        const float inv = powf(10000.0f, -(float)(2 * k) / 64.0f); const float ang = (float)t * inv;
        f32x2 v; v.x = cosf(ang); v.y = sinf(ang); WSP(f32x2, WS_ROPE)[i] = v; }
    { const float* rw = LIN(14, 0);
      for (int i = gt; i < DEPTH * NE * D; i += NGT) { const int l = i / (NE * D), e = (i / D) % NE, k = i % D;
          const float wv = rw[(size_t)l * D * NE + (size_t)k * NE + e]; const unsigned hb = pk2(wv, 0.f) & 0xffffu; const float hf = __uint_as_float(hb << 16);
          bf16* dst = WSP(bf16, WS_RWB) + (size_t)l * 2 * NE * D + (size_t)e * D + k; dst[0] = (bf16)hb; dst[(size_t)NE * D] = (bf16)(pk2(wv - hf, 0.f) & 0xffffu); } }
    for (int i = gt; i < DEPTH * 2 * 4 * 64 * 64; i += NGT) { const int cc = i & 63, d = (i >> 6) & 63, n = (i >> 12) & 3, gate = (i >> 14) & 1, l = i >> 15;
        const float wv = LIN(gate ? 8 : 6, 0)[(size_t)l * 16384 + n * 4096 + cc * 64 + d]; WSP(bf16, WS_RGW)[i] = (bf16)(pk2(wv, 0.f) & 0xffffu); }
    { const f32x4* xs = (const f32x4*)LIN(0, 0); constexpr size_t NCH = (size_t)M * D / 8;
      for (size_t i0 = gt; i0 < NCH; i0 += (size_t)4 * NGT) {
          f32x4 a[4], b[4];
#pragma unroll
          for (int u = 0; u < 4; ++u) { const size_t i = i0 + (size_t)u * NGT; if (i < NCH) { a[u] = __builtin_nontemporal_load(xs + 2 * i); b[u] = __builtin_nontemporal_load(xs + 2 * i + 1); } }
#pragma unroll
          for (int u = 0; u < 4; ++u) { const size_t i = i0 + (size_t)u * NGT; if (i < NCH) { v4u o; o.x = pk2(a[u][0], a[u][1]); o.y = pk2(a[u][2], a[u][3]); o.z = pk2(b[u][0], b[u][1]); o.w = pk2(b[u][2], b[u][3]); WSP(v4u, WS_XB)[i] = o; } } } }
}

#ifndef PROBE_DSA
#define PROBE_DSA 0
#endif
__device__ __forceinline__ unsigned short score_key16(float s) {
    const _Float16 hf = (_Float16)s; const unsigned short h = __builtin_bit_cast(unsigned short, hf);
    return (h & 0x8000u) ? (unsigned short)~h : (unsigned short)(h | 0x8000u);
}
__device__ __forceinline__ void dsa_unit(Frame& F, int b, int qb) {
    PH_IDS; const int g = lane >> 4, li = lane & 15;
    LAS unsigned short* SCK = (LAS unsigned short*)F.lds;
    LAS unsigned* hist = (LAS unsigned*)(F.lctl + LC_HIST + w * 1024);
    const bf16* PJ = WSP(const bf16, WS_PJ);
    const int t0 = qb * 16;
    GAS unsigned long long* MK = (GAS unsigned long long*)WSP(unsigned long long, WS_MASK) + (size_t)(b * T + t0) * 64;
    if (t0 + 15 < 256) {
        for (int idx = tid; idx < 1024; idx += NTHR) { const int r = idx >> 6, l = idx & 63, n = t0 + r + 1 - l * 64;
            MK[idx] = n >= 64 ? ~0ull : (n <= 0 ? 0ull : ((1ull << n) - 1ull)); }
        return;
    }
    __syncthreads();
    {
        const int hh = lane >> 5, l31 = lane & 31;
        const int rq = 2 * (l31 >> 4) + ((l31 >> 2) & 1), rh = 4 * ((l31 >> 3) & 1) + (l31 & 3);
        bf16x8 af[4][4]; float wq[4][16];
#pragma unroll
        for (int rt = 0; rt < 4; ++rt) {
            const bf16* ap = PJ + (size_t)(b * T + t0 + 4 * rt + rq) * NP + C_QI + rh * 64 + 8 * hh;
#pragma unroll
            for (int ks = 0; ks < 4; ++ks) af[rt][ks] = *(const GAS bf16x8*)(ap + ks * 16);
#pragma unroll
            for (int qh = 0; qh < 2; ++qh) {
                const v4u wv = *(const GAS v4u*)(PJ + (size_t)(b * T + t0 + 4 * rt + 2 * qh + hh) * NP + C_W);
                wq[rt][8 * qh + 0] = bflo(wv.x); wq[rt][8 * qh + 1] = bfhi(wv.x); wq[rt][8 * qh + 2] = bflo(wv.y); wq[rt][8 * qh + 3] = bfhi(wv.y);
                wq[rt][8 * qh + 4] = bflo(wv.z); wq[rt][8 * qh + 5] = bfhi(wv.z); wq[rt][8 * qh + 6] = bflo(wv.w); wq[rt][8 * qh + 7] = bfhi(wv.w);
            }
        }
        const int nsub = (t0 + 15) / 32 + 1;
        const bf16* kp = PJ + (size_t)(b * T + l31) * NP + C_KI + 8 * hh;
#define DSA_LOAD(buf, jj) do { const int j_ = (jj) < nsub ? (jj) : 0; _Pragma("unroll") for (int ks = 0; ks < 4; ++ks) buf[ks] = *(const GAS bf16x8*)(kp + (size_t)j_ * 32 * NP + ks * 16); } while (0)
#define DSA_TILE(buf, jj) do { if ((jj) < nsub) { _Pragma("unroll") for (int rt = 0; rt < 4; ++rt) { \
            f32x16 acc; _Pragma("unroll") for (int i = 0; i < 16; ++i) acc[i] = 0.f; \
            _Pragma("unroll") for (int ks = 0; ks < 4; ++ks) acc = __builtin_amdgcn_mfma_f32_32x32x16_bf16(af[rt][ks], buf[ks], acc, 0, 0, 0); \
            float s0 = 0.f, s1 = 0.f; \
            _Pragma("unroll") for (int i = 0; i < 8; ++i) {   \
                const float r0 = __int_as_float(max(__float_as_int(acc[i]), 0)), r1 = __int_as_float(max(__float_as_int(acc[8 + i]), 0)); \
                s0 = fmaf(wq[rt][i], r0, s0); s1 = fmaf(wq[rt][8 + i], r1, s1); } \
            SCK[(4 * rt + hh) * 4096 + (jj) * 32 + l31] = score_key16(s0 + 0.0f); \
            SCK[(4 * rt + 2 + hh) * 4096 + (jj) * 32 + l31] = score_key16(s1 + 0.0f); } } } while (0)
        bf16x8 bX[4], bY[4], bZ[4];
        for (int prep_ = 0; prep_ < (((PROBE_DSA) & 1) ? 2 : 1); ++prep_) {
        DSA_LOAD(bX, w); DSA_LOAD(bY, w + 8);
        for (int j = w; j < nsub; j += 24) {
            DSA_LOAD(bZ, j + 16); DSA_TILE(bX, j);
            DSA_LOAD(bX, j + 24); DSA_TILE(bY, j + 8);
            DSA_LOAD(bY, j + 32); DSA_TILE(bZ, j + 16);
        }
        }
#undef DSA_LOAD
#undef DSA_TILE
    }
    __syncthreads();
#pragma unroll 1
    for (int rr_ = 0; rr_ < ((((PROBE_DSA) >> 1) & 1) ? 4 : 2); ++rr_) {
        const int rr = rr_ & 1;
        const int r = 2 * w + rr, t = t0 + r, ns = (t >> 6) + 1;
        unsigned key[64];
        const LAS unsigned short* kr = SCK + r * 4096 + lane;
#pragma unroll
        for (int g8 = 0; g8 < 8; ++g8) {
            if (g8 * 8 < ns) {
#pragma unroll
                for (int j = 0; j < 8; ++j) { const int i = g8 * 8 + j; const unsigned k = kr[64 * i]; key[i] = (64 * i + lane <= t) ? k : 0u; }
            } else {
#pragma unroll
                for (int j = 0; j < 8; ++j) key[g8 * 8 + j] = 0u;
            }
        }
        unsigned prefix = 0u; int kneed = 256;
#pragma unroll
        for (int pass = 0; pass < 2; ++pass) {
            const int shift = 8 - 8 * pass;
            *(LAS v4u*)(hist + 4 * lane) = (v4u){0u, 0u, 0u, 0u};
#pragma unroll
            for (int g8 = 0; g8 < 8; ++g8) {
                if (g8 * 8 < ns) {
#pragma unroll
                    for (int j = 0; j < 8; ++j) { const unsigned k = key[g8 * 8 + j];
                        const bool m = (k != 0u) && (pass == 0 || (k >> 8) == (prefix >> 8));
                        if (m) atomicAdd((unsigned*)(hist + ((k >> shift) & 255u)), 1u); }
                }
            }
            const v4u c = *(const LAS v4u*)(hist + 4 * lane);
            const int s4 = (int)(c.x + c.y + c.z + c.w);
            const int pre = wave_prefix_incl(s4);
            const int tot = __builtin_amdgcn_readlane(pre, 63);
            int run = tot - pre, fb = -1, fa = 0;
            if (run < kneed && kneed <= run + (int)c.w) { fb = 4 * lane + 3; fa = run; } run += (int)c.w;
            if (fb < 0 && run < kneed && kneed <= run + (int)c.z) { fb = 4 * lane + 2; fa = run; } run += (int)c.z;
            if (fb < 0 && run < kneed && kneed <= run + (int)c.y) { fb = 4 * lane + 1; fa = run; } run += (int)c.y;
            if (fb < 0 && run < kneed && kneed <= run + (int)c.x) { fb = 4 * lane + 0; fa = run; }
            const unsigned long long bm = __builtin_amdgcn_ballot_w64(fb >= 0);
            const int src = bm ? (int)__builtin_ctzll(bm) : 0;
            const int bsel = __builtin_amdgcn_readlane(fb, src), asel = __builtin_amdgcn_readlane(fa, src);
            prefix |= ((unsigned)bsel & 255u) << shift; kneed -= asel;
        }
        const unsigned thr = prefix;
        int remaining = kneed;
        unsigned long long word = 0ull;
#pragma unroll
        for (int g8 = 0; g8 < 8; ++g8) {
            if (g8 * 8 < ns) {
#pragma unroll
                for (int j = 0; j < 8; ++j) { const int i = g8 * 8 + j;
                    const unsigned long long gm = __builtin_amdgcn_ballot_w64(key[i] > thr); unsigned long long em = __builtin_amdgcn_ballot_w64(key[i] == thr);
                    int ne = __popcll(em);
                    if (ne > remaining) { while (__popcll(em) > remaining) em &= ~(1ull << (63 - __clzll((long long)em))); ne = remaining; }
                    remaining -= ne;
                    const unsigned long long wi = gm | em;
                    word = (lane == i) ? wi : word; }
            }
        }
        MK[r * 64 + lane] = word;
    }
}
__device__ __forceinline__ void ret_state_unit(Frame& F, int b, int h, int c) {
    PH_IDS;
    constexpr int TP = 136;
    LAS bf16* KT = (LAS bf16*)F.lds;
    LAS bf16* VT = KT + 64 * TP;
    const bf16* PJ = WSP(const bf16, WS_PJ);
    const float lg = log2f(1.0f - exp2f(-5.0f - (float)h));
    __syncthreads();
    {
        v4u kv[2], vv[2];
#pragma unroll
        for (int i = 0; i < 2; ++i) { const int idx = tid + NTHR * i, r = idx >> 3, cc = idx & 7;
            const size_t rb = (size_t)(b * T + c * 128 + r) * NP + h * 64 + cc * 8;
            kv[i] = *(const GAS v4u*)(PJ + rb + C_RK); vv[i] = *(const GAS v4u*)(PJ + rb + C_RV); }
#pragma unroll
        for (int i = 0; i < 2; ++i) { const int idx = tid + NTHR * i, r = idx >> 3, cc = idx & 7;
            const float z = exp2f((float)(127 - r) * lg);
            const unsigned k01 = pk2(bflo(kv[i].x) * z, bfhi(kv[i].x) * z), k23 = pk2(bflo(kv[i].y) * z, bfhi(kv[i].y) * z), k45 = pk2(bflo(kv[i].z) * z, bfhi(kv[i].z) * z), k67 = pk2(bflo(kv[i].w) * z, bfhi(kv[i].w) * z);
            LAS bf16* kd = KT + (cc * 8) * TP + r; LAS bf16* vd = VT + (cc * 8) * TP + r;
            kd[0 * TP] = (bf16)(k01 & 0xffffu); kd[1 * TP] = (bf16)(k01 >> 16); kd[2 * TP] = (bf16)(k23 & 0xffffu); kd[3 * TP] = (bf16)(k23 >> 16);
            kd[4 * TP] = (bf16)(k45 & 0xffffu); kd[5 * TP] = (bf16)(k45 >> 16); kd[6 * TP] = (bf16)(k67 & 0xffffu); kd[7 * TP] = (bf16)(k67 >> 16);
            vd[0 * TP] = (bf16)(vv[i].x & 0xffffu); vd[1 * TP] = (bf16)(vv[i].x >> 16); vd[2 * TP] = (bf16)(vv[i].y & 0xffffu); vd[3 * TP] = (bf16)(vv[i].y >> 16);
            vd[4 * TP] = (bf16)(vv[i].z & 0xffffu); vd[5 * TP] = (bf16)(vv[i].z >> 16); vd[6 * TP] = (bf16)(vv[i].w & 0xffffu); vd[7 * TP] = (bf16)(vv[i].w >> 16); }
    }
    __syncthreads();
    const int et = w >> 1, dt0 = (w & 1) * 2, j = lane & 15, g = lane >> 4;
    f32x4 acc0 = {0.f, 0.f, 0.f, 0.f}, acc1 = {0.f, 0.f, 0.f, 0.f};
#pragma unroll
    for (int ks = 0; ks < 4; ++ks) {
        const bf16x8 af = *(const LAS bf16x8*)(VT + (et * 16 + j) * TP + ks * 32 + 8 * g);
        const bf16x8 b0 = *(const LAS bf16x8*)(KT + (dt0 * 16 + j) * TP + ks * 32 + 8 * g), b1 = *(const LAS bf16x8*)(KT + ((dt0 + 1) * 16 + j) * TP + ks * 32 + 8 * g);
        acc0 = mfma16(af, b0, acc0); acc1 = mfma16(af, b1, acc1);
    }
    float* dst = WSP(float, WS_ST) + ((size_t)((b * 4 + h) * 32 + c) * 64 + et * 16 + 4 * g) * 64 + dt0 * 16 + j;
#pragma unroll
    for (int r = 0; r < 4; ++r) { dst[(size_t)r * 64] = acc0[r]; dst[(size_t)r * 64 + 16] = acc1[r]; }
}
__device__ __forceinline__ void kmean_unit(Frame& F, int b, int n) {
    PH_IDS;
    LAS float* part = (LAS float*)F.lds;
    LAS float* nmax = part + 16 * 256;
    const bf16* PJ = WSP(const bf16, WS_PJ);
    const int ch = tid & 31, rgp = tid >> 5;
    __syncthreads();
#pragma unroll
    for (int kind = 0; kind < 2; ++kind) {
        v4u v[16];
#pragma unroll
        for (int i = 0; i < 16; ++i) v[i] = *(const GAS v4u*)(PJ + (size_t)(b * T + n * 256 + rgp + 16 * i) * NP + (kind == 0 ? C_AK : C_DK) + ch * 8);
        float a8[8], m2 = 0.f;
#pragma unroll
        for (int k = 0; k < 8; ++k) a8[k] = 0.f;
#pragma unroll
        for (int i = 0; i < 16; ++i) {
            const float x0 = bflo(v[i].x), x1 = bfhi(v[i].x), x2 = bflo(v[i].y), x3 = bfhi(v[i].y), x4 = bflo(v[i].z), x5 = bfhi(v[i].z), x6 = bflo(v[i].w), x7 = bfhi(v[i].w);
            a8[0] += x0; a8[1] += x1; a8[2] += x2; a8[3] += x3; a8[4] += x4; a8[5] += x5; a8[6] += x6; a8[7] += x7;
            float ss = (x0 * x0 + x1 * x1) + (x2 * x2 + x3 * x3) + (x4 * x4 + x5 * x5) + (x6 * x6 + x7 * x7);
            ss += __shfl_xor(ss, 1); ss += __shfl_xor(ss, 2); ss += __shfl_xor(ss, 4);
            m2 = fmaxf(m2, ss);
        }
        if (kind == 0) {
#pragma unroll
            for (int k = 0; k < 8; ++k) part[rgp * 256 + ch * 8 + k] = a8[k];
        }
        if ((ch & 7) == 0) nmax[(kind * 16 + rgp) * 4 + (ch >> 3)] = m2;
    }
    __syncthreads();
    if (tid < 256) { float sum = 0.f;
#pragma unroll
        for (int r = 0; r < 16; ++r) sum += part[r * 256 + tid];
        WSP(bf16, WS_KMB)[((size_t)(b * 4 + (tid >> 6)) * 16 + n) * 64 + (tid & 63)] = (bf16)(pk2(sum * (1.0f / 256.0f), 0.f) & 0xffffu); }
    if (tid < 8) { const int kind = tid >> 2, hd = tid & 3; float m2 = 0.f;
#pragma unroll
        for (int r = 0; r < 16; ++r) m2 = fmaxf(m2, nmax[(kind * 16 + r) * 4 + hd]);
        WSP(float, WS_KN2)[((size_t)(kind * NB + b) * 4 + hd) * 16 + n] = m2; }
}
__device__ __forceinline__ void rg_local_unit(Frame& F, int b, int k) {
    PH_IDS;
    LAS float* XC = (LAS float*)F.lds;
    LAS float* AS = XC + 64 * 256;
    const bf16* PJ = WSP(const bf16, WS_PJ);
    const int c = tid & 255, th = tid >> 8;
    const int t0 = k * 64;
    const int gn = w >> 1, gh = w & 1, gj = lane & 15, gg = lane >> 4;
    bf16x8 bw[2][4][2];
    { const bf16* wt = WSP(const bf16, WS_RGW) + (size_t)F.layer * 32768 + (size_t)gn * 4096 + gj * 64 + 8 * gg;
#pragma unroll
      for (int gate = 0; gate < 2; ++gate)
#pragma unroll
          for (int dt = 0; dt < 4; ++dt)
#pragma unroll
              for (int ks = 0; ks < 2; ++ks) bw[gate][dt][ks] = *(const GAS bf16x8*)(wt + gate * 16384 + dt * 1024 + ks * 32); }
    __syncthreads();
    {
        LAS bf16* RAW = (LAS bf16*)AS;
        v4u rv[5];
#pragma unroll
        for (int i = 0; i < 5; ++i) { const int idx = tid + NTHR * i, rr = idx >> 5, cc = idx & 31, t = t0 - 3 + rr;
            rv[i] = (idx < 67 * 32 && t >= 0) ? *(const GAS v4u*)(PJ + (size_t)(b * T + t) * NP + C_CX + cc * 8) : (v4u){0u, 0u, 0u, 0u}; }
#pragma unroll
        for (int i = 0; i < 5; ++i) { const int idx = tid + NTHR * i; if (idx < 67 * 32) *(LAS v4u*)(RAW + idx * 8) = rv[i]; }
        __syncthreads();
        const float* cw_ = LIN(4, 1024);
        const float w0 = cw_[0 * 256 + c], w1 = cw_[1 * 256 + c], w2 = cw_[2 * 256 + c], w3 = cw_[3 * 256 + c], cb = LIN(5, 256)[c];
#pragma unroll 8
        for (int i = 0; i < 32; ++i) { const int tl = th + 2 * i;
            XC[tl * 256 + c] = cb + w0 * bf2f(RAW[tl * 256 + c]) + w1 * bf2f(RAW[(tl + 1) * 256 + c]) + w2 * bf2f(RAW[(tl + 2) * 256 + c]) + w3 * bf2f(RAW[(tl + 3) * 256 + c]); }
    }
    __syncthreads();
    float bt[2][4][4];
    {
        f32x4 ax[2][4], aa[2][4];
#pragma unroll
        for (int tt2 = 0; tt2 < 2; ++tt2)
#pragma unroll
            for (int dt = 0; dt < 4; ++dt) { ax[tt2][dt] = (f32x4){0.f, 0.f, 0.f, 0.f}; aa[tt2][dt] = (f32x4){0.f, 0.f, 0.f, 0.f}; }
#pragma unroll
        for (int tt2 = 0; tt2 < 2; ++tt2)
#pragma unroll
            for (int ks = 0; ks < 2; ++ks) {
                const LAS float* xp = XC + ((gh * 2 + tt2) * 16 + gj) * 256 + gn * 64 + ks * 32 + 8 * gg;
                const f32x4 x0 = *(const LAS f32x4*)xp, x1 = *(const LAS f32x4*)(xp + 4);
                v4u pa; pa.x = pk2(x0[0], x0[1]); pa.y = pk2(x0[2], x0[3]); pa.z = pk2(x1[0], x1[1]); pa.w = pk2(x1[2], x1[3]);
                const bf16x8 af = __builtin_bit_cast(bf16x8, pa);
#pragma unroll
                for (int dt = 0; dt < 4; ++dt) { ax[tt2][dt] = mfma16(af, bw[0][dt][ks], ax[tt2][dt]); aa[tt2][dt] = mfma16(af, bw[1][dt][ks], aa[tt2][dt]); }
            }
#pragma unroll
        for (int dt = 0; dt < 4; ++dt) {
            const int cch = gn * 64 + dt * 16 + gj;
            const float bx = LIN(7, 256)[cch], ba = LIN(9, 256)[cch], lam = LIN(10, 256)[cch];
            const float sp = log1pf(expf(-lam));
#pragma unroll
            for (int tt2 = 0; tt2 < 2; ++tt2)
#pragma unroll
                for (int r = 0; r < 4; ++r) {
                    const int tl = (gh * 2 + tt2) * 16 + 4 * gg + r;
                    const float gx = sigmoidf_(ax[tt2][dt][r] + bx), ga = sigmoidf_(aa[tt2][dt][r] + ba);
                    const float la = -8.0f * ga * sp; const float a = expf(la);
                    bt[tt2][dt][r] = sqrtf(-expm1f(2.0f * la)) * (gx * XC[tl * 256 + cch]);
                    AS[tl * 256 + cch] = a;
                }
        }
    }
    __syncthreads();
#pragma unroll
    for (int dt = 0; dt < 4; ++dt)
#pragma unroll
        for (int tt2 = 0; tt2 < 2; ++tt2)
#pragma unroll
            for (int r = 0; r < 4; ++r) XC[((gh * 2 + tt2) * 16 + 4 * gg + r) * 256 + gn * 64 + dt * 16 + gj] = bt[tt2][dt][r];
    __syncthreads();
    if (tid < 256) {
        float h = 0.f, P = 1.f;
        float* hl = WSP(float, WS_HLOC) + (size_t)(b * T + t0) * 256 + c; float* pc = WSP(float, WS_PC) + (size_t)(b * T + t0) * 256 + c;
        for (int tl = 0; tl < 64; ++tl) { const float a = AS[tl * 256 + c], bb = XC[tl * 256 + c]; h = fmaf(a, h, bb); P *= a; hl[(size_t)tl * 256] = h; pc[(size_t)tl * 256] = P; }
        WSP(float, WS_RGS)[(size_t)(b * 64 + k) * 256 + c] = P;
        WSP(float, WS_RGS)[(size_t)131072 + (size_t)(b * 64 + k) * 256 + c] = h;
    }
}

__device__ __forceinline__ void ret_prefix(Frame& F) {
    PH_IDS; const int gt = bid_ * NTHR + tid, NGT = G_ * NTHR;
    for (int i = gt; i < 32 * 4096; i += NGT) {
        const int bh = i >> 12, idx = i & 4095, h = bh & 3;
        const float gc = exp2f(128.0f * log2f(1.0f - exp2f(-5.0f - (float)h)));
        const float* st = WSP(const float, WS_ST) + (size_t)bh * 32 * 4096 + idx; bf16* rt = WSP(bf16, WS_RT) + (size_t)bh * 32 * 4096 + idx;
        float R = 0.f;
        for (int c = 0; c < 32; ++c) { rt[(size_t)c * 4096] = (bf16)(pk2(R, 0.f) & 0xffffu); R = st[(size_t)c * 4096] + gc * R; }
    }
}
__device__ __forceinline__ void rg_carry(Frame& F) {
    PH_IDS; const int gt = bid_ * NTHR + tid, NGT = G_ * NTHR;
    float* S = WSP(float, WS_RGS);
    for (int i = gt; i < NB * 256; i += NGT) {
        const int b = i >> 8, c = i & 255;
        float h = 0.f;
        for (int k = 0; k < 64; ++k) { const size_t o = (size_t)(b * 64 + k) * 256 + c; S[262144 + o] = h; h = fmaf(S[o], h, S[131072 + o]); }
    }
}

__device__ __forceinline__ bf16x8 pack8(const f32x4& a, const f32x4& b) {
    v4u w; w.x = pk2(a[0], a[1]); w.y = pk2(a[2], a[3]); w.z = pk2(b[0], b[1]); w.w = pk2(b[2], b[3]);
    return __builtin_bit_cast(bf16x8, w);
}
template <int MODE>
__device__ __forceinline__ void attn_unit(Frame& F, int b, int h, int qt) {
    PH_IDS; const int g = lane >> 4, li = lane & 15;
    LAS bf16* LB = (LAS bf16*)F.lds;
    LAS unsigned* wgsel = (LAS unsigned*)(F.lds + 2 * 9216 * 2);
    LAS v2u* plut = (LAS v2u*)(F.lds + 2 * 9216 * 2 + 64);
    const bf16* PJ = WSP(const bf16, WS_PJ);
    constexpr int qoff = MODE == 0 ? C_DQ : (MODE == 1 ? C_AQ : C_RQ), koff = MODE == 0 ? C_DK : (MODE == 1 ? C_AK : C_RK), voff = MODE == 0 ? C_DV : (MODE == 1 ? C_AV : C_RV);
    constexpr int ocol = MODE == 0 ? 768 : (MODE == 1 ? 0 : 256);
    const int q0 = qt * 256 + w * 32, wqmax = q0 + 31;
    bf16x8 qf[2][2];
#pragma unroll
    for (int qq = 0; qq < 2; ++qq)
#pragma unroll
        for (int ks = 0; ks < 2; ++ks) qf[qq][ks] = *(const GAS bf16x8*)(PJ + (size_t)(b * T + q0 + qq * 16 + li) * NP + qoff + h * 64 + ks * 32 + g * 8);
    f32x4 O[2][4], OL[2]; unsigned sel[2]; f32x4 negb[2];
#pragma unroll
    for (int qq = 0; qq < 2; ++qq) { sel[qq] = 0u; OL[qq] = (f32x4){0.f, 0.f, 0.f, 0.f}; negb[qq] = (f32x4){0.f, 0.f, 0.f, 0.f};
#pragma unroll
        for (int dt = 0; dt < 4; ++dt) O[qq][dt] = (f32x4){0.f, 0.f, 0.f, 0.f}; }
    unsigned wsel = 0xffffffffu;
    const float lg = (MODE == 2) ? log2f(1.0f - exp2f(-5.0f - (float)h)) : 0.f;
    if (MODE != 2) {
        const float* kn = WSP(const float, WS_KN2) + ((size_t)((MODE == 0 ? NB : 0) + b) * 4 + h) * 16;
        float km2 = 0.f;
        for (int n = 0; n <= qt; ++n) km2 = fmaxf(km2, kn[n]);
#pragma unroll
        for (int qq = 0; qq < 2; ++qq) {
            float q2 = 0.f;
#pragma unroll
            for (int ks = 0; ks < 2; ++ks) { const v4u qw = __builtin_bit_cast(v4u, qf[qq][ks]);
                q2 += (bflo(qw.x) * bflo(qw.x) + bfhi(qw.x) * bfhi(qw.x)) + (bflo(qw.y) * bflo(qw.y) + bfhi(qw.y) * bfhi(qw.y)) + (bflo(qw.z) * bflo(qw.z) + bfhi(qw.z) * bfhi(qw.z)) + (bflo(qw.w) * bflo(qw.w) + bfhi(qw.w) * bfhi(qw.w)); }
            q2 += __shfl_xor(q2, 16); q2 += __shfl_xor(q2, 32);
            const float bq = fminf(sqrtf(q2 * km2) * 1.001f + 1e-3f, 60.0f);
            negb[qq] = (f32x4){-bq, -bq, -bq, -bq};
        }
    }
    __syncthreads();
    if (tid < 16) { v2u e; e.x = ((tid & 1) ? 0xffffu : 0u) | ((tid & 2) ? 0xffff0000u : 0u); e.y = ((tid & 4) ? 0xffffu : 0u) | ((tid & 8) ? 0xffff0000u : 0u); plut[tid] = e; }
    if (MODE == 1) {
        const int own = qt;
        if (tid == 0) *wgsel = 0u;
        const bf16* km = WSP(const bf16, WS_KMB) + ((size_t)(b * 4 + h) * 16 + li) * 64;
        const bf16x8 km0 = *(const GAS bf16x8*)(km + g * 8), km1 = *(const GAS bf16x8*)(km + 32 + g * 8);
#pragma unroll
        for (int qq = 0; qq < 2; ++qq) {
            f32x4 gt4 = {0.f, 0.f, 0.f, 0.f};
            gt4 = mfma16(km0, qf[qq][0], gt4); gt4 = mfma16(km1, qf[qq][1], gt4);
            unsigned sq = 0u;
#pragma unroll
            for (int round = 0; round < 3; ++round) {
                float bv = -INFINITY; int bn = 99;
#pragma unroll
                for (int r = 0; r < 4; ++r) { const int n = g * 4 + r; if (n < own && !((sq >> n) & 1u) && gt4[r] > bv) { bv = gt4[r]; bn = n; } }
#pragma unroll
                for (int o = 16; o <= 32; o <<= 1) { const float ov = __shfl_xor(bv, o); const int on = __shfl_xor(bn, o); if (ov > bv || (ov == bv && on < bn)) { bv = ov; bn = on; } }
                if (bn < 16) sq |= 1u << bn;
            }
            sel[qq] = sq | (1u << own);
        }
        __syncthreads();
        if (g == 0) atomicOr((unsigned*)wgsel, sel[0] | sel[1]);
        __syncthreads();
        wsel = *wgsel;
    }
    const int kt_lo = (MODE == 2) ? 4 * qt : 0, kt_hi = 4 * qt + 3;
    const int sr = tid >> 3, sc = tid & 7;
    int kt = kt_lo;
    if (MODE == 1) { while (kt <= kt_hi && !((wsel >> (kt >> 2)) & 1u)) kt = (kt | 3) + 1; }
    v4u kreg, vreg;
    { const size_t rb = (size_t)(b * T + kt * 64 + sr) * NP + h * 64 + sc * 8; kreg = *(const GAS v4u*)(PJ + rb + koff); vreg = *(const GAS v4u*)(PJ + rb + voff); }
    const GAS unsigned long long* mkp = (const GAS unsigned long long*)WSP(const unsigned long long, WS_MASK) + (size_t)(b * T + q0 + li) * 64;
    unsigned long long mnx0 = ~0ull, mnx1 = ~0ull;
    if (MODE == 0) { mnx0 = mkp[kt]; mnx1 = mkp[16 * 64 + kt]; }
    const v4u onesw = (li == 0) ? (v4u){0x3f803f80u, 0x3f803f80u, 0x3f803f80u, 0x3f803f80u} : (v4u){0u, 0u, 0u, 0u};
    const bf16x8 onesf = __builtin_bit_cast(bf16x8, onesw);
    const f32x4 ninf4 = {-INFINITY, -INFINITY, -INFINITY, -INFINITY};
    int cur = 0;
    while (kt <= kt_hi) {
        LAS bf16* Ks = LB + cur * 9216; LAS bf16* Vt = Ks + 4608;
        *(LAS v4u*)(Ks + sr * 72 + sc * 8) = kreg;
        { LAS bf16* vd = Vt + (sc * 8) * 72 + (sr ^ (sc << 3));
          vd[0 * 72] = (bf16)(vreg.x & 0xffffu); vd[1 * 72] = (bf16)(vreg.x >> 16); vd[2 * 72] = (bf16)(vreg.y & 0xffffu); vd[3 * 72] = (bf16)(vreg.y >> 16);
          vd[4 * 72] = (bf16)(vreg.z & 0xffffu); vd[5 * 72] = (bf16)(vreg.z >> 16); vd[6 * 72] = (bf16)(vreg.w & 0xffffu); vd[7 * 72] = (bf16)(vreg.w >> 16); }
        __syncthreads();
        int ktn = kt + 1;
        if (MODE == 1) { while (ktn <= kt_hi && !((wsel >> (ktn >> 2)) & 1u)) ktn = (ktn | 3) + 1; }
        if (ktn <= kt_hi) { const size_t rb = (size_t)(b * T + ktn * 64 + sr) * NP + h * 64 + sc * 8; kreg = *(const GAS v4u*)(PJ + rb + koff); vreg = *(const GAS v4u*)(PJ + rb + voff); }
        const unsigned long long mcu0 = mnx0, mcu1 = mnx1;
        if (MODE == 0 && ktn <= kt_hi) { mnx0 = mkp[ktn]; mnx1 = mkp[16 * 64 + ktn]; }
        const bool diag = (kt * 64 + 63 > q0);
        const bool masked = (MODE == 0) || (MODE == 2) || diag;
        unsigned long long mwq[2]; f32x4 cin[2];
#pragma unroll
        for (int qq = 0; qq < 2; ++qq) {
            const int tqq = q0 + qq * 16 + li, d = tqq - kt * 64;
            unsigned long long cm = d >= 63 ? ~0ull : (d < 0 ? 0ull : ((2ull << d) - 1ull));
            if (MODE == 0) cm &= (qq == 0 ? mcu0 : mcu1);
            mwq[qq] = cm;
            cin[qq] = negb[qq];
            if (MODE == 1) cin[qq] = ((sel[qq] >> (kt >> 2)) & 1u) ? negb[qq] : ninf4;
        }
#pragma unroll
        for (int sub = 0; sub < 2; ++sub) {
            if (kt * 64 + sub * 32 > wqmax) continue;
            bf16x8 k0[2], k1[2];
#pragma unroll
            for (int ks = 0; ks < 2; ++ks) { k0[ks] = *(const LAS bf16x8*)(Ks + (sub * 32 + li) * 72 + ks * 32 + g * 8); k1[ks] = *(const LAS bf16x8*)(Ks + (sub * 32 + 16 + li) * 72 + ks * 32 + g * 8); }
            bf16x8 pb[2];
#pragma unroll
            for (int qq = 0; qq < 2; ++qq) {
                f32x4 s0, s1;
                if (MODE == 2) { s0 = (f32x4){0.f, 0.f, 0.f, 0.f}; s1 = s0; } else { s0 = cin[qq]; s1 = cin[qq]; }
                s0 = mfma16(k0[0], qf[qq][0], s0); s1 = mfma16(k1[0], qf[qq][0], s1); s0 = mfma16(k0[1], qf[qq][1], s0); s1 = mfma16(k1[1], qf[qq][1], s1);
                const unsigned nib0 = (unsigned)(mwq[qq] >> (sub * 32 + g * 4)) & 15u, nib1 = (unsigned)(mwq[qq] >> (sub * 32 + 16 + g * 4)) & 15u;
                if (MODE == 2) {
                    f32x4 p0, p1;
                    const int tqq = q0 + qq * 16 + li, kk0 = kt * 64 + sub * 32 + g * 4, kk1 = kk0 + 16;
#pragma unroll
                    for (int r = 0; r < 4; ++r) {
                        p0[r] = ((nib0 >> r) & 1u) ? s0[r] * __builtin_amdgcn_exp2f((float)(tqq - kk0 - r) * lg) : 0.f;
                        p1[r] = ((nib1 >> r) & 1u) ? s1[r] * __builtin_amdgcn_exp2f((float)(tqq - kk1 - r) * lg) : 0.f;
                    }
                    pb[qq] = pack8(p0, p1);
                } else {
                    f32x4 p0, p1;
#pragma unroll
                    for (int r = 0; r < 4; ++r) { p0[r] = __builtin_amdgcn_exp2f(s0[r]); p1[r] = __builtin_amdgcn_exp2f(s1[r]); }
                    v4u pw = __builtin_bit_cast(v4u, pack8(p0, p1));
                    if (masked) { const v2u ma = plut[nib0], mb = plut[nib1]; pw.x &= ma.x; pw.y &= ma.y; pw.z &= mb.x; pw.w &= mb.y; }
                    pb[qq] = __builtin_bit_cast(bf16x8, pw);
                }
            }
#pragma unroll
            for (int dt = 0; dt < 4; ++dt) {
                const int dim = dt * 16 + li, swz = ((dim >> 3) & 7) << 3;
                const LAS bf16* vrow = Vt + dim * 72;
                const v2u va = *(const LAS v2u*)(vrow + ((sub * 32 + g * 4) ^ swz)), vb = *(const LAS v2u*)(vrow + ((sub * 32 + 16 + g * 4) ^ swz));
                v4u vw; vw.x = va.x; vw.y = va.y; vw.z = vb.x; vw.w = vb.y;
                const bf16x8 vf = __builtin_bit_cast(bf16x8, vw);
                O[0][dt] = mfma16(vf, pb[0], O[0][dt]); O[1][dt] = mfma16(vf, pb[1], O[1][dt]);
            }
            if (MODE != 2) { OL[0] = mfma16(onesf, pb[0], OL[0]); OL[1] = mfma16(onesf, pb[1], OL[1]); }
        }
        kt = ktn; cur ^= 1;
    }
    bf16* MX = WSP(bf16, WS_MIX);
#pragma unroll
    for (int qq = 0; qq < 2; ++qq) {
        const int tqq = q0 + qq * 16 + li; const size_t qrow = (size_t)(b * T + tqq);
        if (MODE != 2) {
            const float lt = __shfl(OL[qq][0], li);
            const float inv = __builtin_amdgcn_rcpf(lt);
#pragma unroll
            for (int dt = 0; dt < 4; ++dt) { v2u o; o.x = pk2(O[qq][dt][0] * inv, O[qq][dt][1] * inv); o.y = pk2(O[qq][dt][2] * inv, O[qq][dt][3] * inv);
                *(GAS v2u*)(MX + qrow * D + ocol + h * 64 + dt * 16 + g * 4) = o; }
        } else {
            const bf16* rt = WSP(const bf16, WS_RT) + (size_t)((b * 4 + h) * 32 + 2 * qt) * 4096;
            const float xi = exp2f((float)((tqq & 255) + 1) * lg);
#pragma unroll
            for (int dt = 0; dt < 4; ++dt) {
                f32x4 cr = {0.f, 0.f, 0.f, 0.f};
                cr = mfma16(*(const GAS bf16x8*)(rt + (dt * 16 + li) * 64 + g * 8), qf[qq][0], cr); cr = mfma16(*(const GAS bf16x8*)(rt + (dt * 16 + li) * 64 + 32 + g * 8), qf[qq][1], cr);
                O[qq][dt] = O[qq][dt] + cr * xi;
            }
            float s = 0.f;
#pragma unroll
            for (int dt = 0; dt < 4; ++dt) s += (O[qq][dt][0] + O[qq][dt][1]) + (O[qq][dt][2] + O[qq][dt][3]);
            s += __shfl_xor(s, 16); s += __shfl_xor(s, 32);
            const float mu = s * (1.0f / 64.0f);
            float q = 0.f;
#pragma unroll
            for (int dt = 0; dt < 4; ++dt) { const f32x4 dd = O[qq][dt] - mu; q += (dd[0] * dd[0] + dd[1] * dd[1]) + (dd[2] * dd[2] + dd[3] * dd[3]); }
            q += __shfl_xor(q, 16); q += __shfl_xor(q, 32);
            const float rstd = 1.0f / sqrtf(q * (1.0f / 64.0f) + LN_EPS);
#pragma unroll
            for (int dt = 0; dt < 4; ++dt) {
                const int e0 = h * 64 + dt * 16 + g * 4;
                const f32x4 gg = *(const f32x4*)(LIN(2, 256) + e0), gb = *(const f32x4*)(LIN(3, 256) + e0);
                const v2u rg = *(const GAS v2u*)(PJ + qrow * NP + C_RG + e0);
                const float r0 = bflo(rg.x), r1 = bfhi(rg.x), r2 = bflo(rg.y), r3 = bfhi(rg.y);
                const float y0 = ((O[qq][dt][0] - mu) * rstd * gg[0] + gb[0]) * (r0 * sigmoidf_(r0)), y1 = ((O[qq][dt][1] - mu) * rstd * gg[1] + gb[1]) * (r1 * sigmoidf_(r1));
                const float y2 = ((O[qq][dt][2] - mu) * rstd * gg[2] + gb[2]) * (r2 * sigmoidf_(r2)), y3 = ((O[qq][dt][3] - mu) * rstd * gg[3] + gb[3]) * (r3 * sigmoidf_(r3));
                v2u o; o.x = pk2(y0, y1); o.y = pk2(y2, y3);
                *(GAS v2u*)(MX + qrow * D + ocol + e0) = o;
            }
        }
    }
}
__device__ __forceinline__ void rg_final_unit(Frame& F, int b, int k) {
    PH_IDS;
    const bf16* PJ = WSP(const bf16, WS_PJ); bf16* MX = WSP(bf16, WS_MIX);
    const int c4 = (tid & 63) * 4, tr = tid >> 6;
    const f32x4 hin = *(const f32x4*)(WSP(const float, WS_RGS) + 262144 + (size_t)(b * 64 + k) * 256 + c4);
    for (int i = 0; i < 8; ++i) {
        const size_t row = (size_t)(b * T + k * 64 + tr + 8 * i);
        const f32x4 hl = *(const f32x4*)(WSP(const float, WS_HLOC) + row * 256 + c4), pc = *(const f32x4*)(WSP(const float, WS_PC) + row * 256 + c4);
        const v2u gv = *(const GAS v2u*)(PJ + row * NP + C_CG + c4);
        const float gx[4] = {bflo(gv.x), bfhi(gv.x), bflo(gv.y), bfhi(gv.y)};
        float o[4];
#pragma unroll
        for (int j = 0; j < 4; ++j) { const float hh = fmaf(pc[j], hin[j], hl[j]); const float x = gx[j];
            const float ge = 0.5f * x * (1.0f + tanhf(0.7978845608028654f * (x + 0.044715f * x * x * x))); o[j] = hh * ge; }
        v2u ov; ov.x = pk2(o[0], o[1]); ov.y = pk2(o[2], o[3]);
        *(GAS v2u*)(MX + row * D + 512 + c4) = ov;
    }
}

__device__ __forceinline__ int moe_tables(Frame& F) {
    PH_IDS; LAS int* off = (LAS int*)(F.lctl + LC_OFF); LAS int* ptab = (LAS int*)(F.lctl + LC_PTAB);
    __syncthreads();
    if (tid == 0) {
        int o = 0;
        LAS int* cn = (LAS int*)(F.lctl + LC_CNT);
        for (int e = 0; e < NE; ++e) { off[e] = o; const int c = (int)__hip_atomic_load(F.ctl + CW_CNT + (F.layer * NE + e) * 64, RLX_AGENT); cn[e] = c; o += (c + 255) & ~255; }
        off[NE] = o;
    }
    __syncthreads();
    for (int p = tid; p < MAXPANELS; p += NTHR) { int e = 0;
        for (int k = 1; k < NE; ++k) e += (p * 256 >= off[k]) ? 1 : 0;
        ptab[p] = e; }
    __syncthreads();
    return off[NE] >> 8;
}
__device__ __forceinline__ void router_phase(Frame& F, const bool dry = false) {
    PH_IDS; const int g_ph = lane >> 4, li_ph = lane & 15;
    LAS float* LG = (LAS float*)F.lds + w * 512;
    LAS int* wcnt = (LAS int*)(F.lctl + LC_WCNT); LAS int* wbase = wcnt + 32;
    LAS int* rec = (LAS int*)(F.lctl + LC_REC);
    const bf16* Y1 = WSP(const bf16, WS_Y1); bf16* X1B = dry ? WSP(bf16, WS_XP) : WSP(bf16, WS_X1B);
    int* TOKO = dry ? (int*)(wsl + WS_XP + 64 * MiB) : WSP(int, WS_TOK); const int cofs = dry ? 2 * NE * 64 : 0;
    int* RT2 = dry ? (int*)(wsl + WS_XP + 80 * MiB) : WSP(int, WS_ROWTOK);
    const float* gamp = LIN(12, 1024); const float* betp = LIN(13, 1024); const float* rbp = LIN(15, 32);
    const bf16* rwb = WSP(const bf16, WS_RWB) + (size_t)F.layer * 2 * NE * D;
    __syncthreads();
    for (int rg = bid_; rg < M / 128; rg += G_) {
        if (tid < 32) wcnt[tid] = 0;
        __syncthreads();
        const size_t r0 = (size_t)rg * 128 + w * 16;
        int li = li_ph, g = g_ph; asm volatile("" : "+v"(li), "+v"(g));
        v4u xr[32];
        { const bf16* xrow = Y1 + (r0 + li) * D + g * 8;
#pragma unroll
          for (int ks = 0; ks < 32; ++ks) xr[ks] = *(const GAS v4u*)(xrow + ks * 32); }
        float s = 0.f;
#pragma unroll
        for (int ks = 0; ks < 32; ++ks) s += ((bflo(xr[ks].x) + bfhi(xr[ks].x)) + (bflo(xr[ks].y) + bfhi(xr[ks].y))) + ((bflo(xr[ks].z) + bfhi(xr[ks].z)) + (bflo(xr[ks].w) + bfhi(xr[ks].w)));
        s += __shfl_xor(s, 16); s += __shfl_xor(s, 32);
        const float mean = s * (1.0f / D);
#define XR_LAUNDER() _Pragma("unroll") for (int ks = 0; ks < 32; ++ks) asm volatile("" : "+v"(xr[ks]))
        XR_LAUNDER();
        float s2 = 0.f;
#pragma unroll
        for (int ks = 0; ks < 32; ++ks) { const float d0 = bflo(xr[ks].x) - mean, d1 = bfhi(xr[ks].x) - mean, d2 = bflo(xr[ks].y) - mean, d3 = bfhi(xr[ks].y) - mean, d4 = bflo(xr[ks].z) - mean, d5 = bfhi(xr[ks].z) - mean, d6 = bflo(xr[ks].w) - mean, d7 = bfhi(xr[ks].w) - mean;
            s2 += ((d0 * d0 + d1 * d1) + (d2 * d2 + d3 * d3)) + ((d4 * d4 + d5 * d5) + (d6 * d6 + d7 * d7)); }
        s2 += __shfl_xor(s2, 16); s2 += __shfl_xor(s2, 32);
        const float rstd = 1.0f / sqrtf(s2 * (1.0f / D) + LN_EPS);
        XR_LAUNDER();
#undef XR_LAUNDER
        f32x4 acc0 = {0.f, 0.f, 0.f, 0.f}, acc1 = {0.f, 0.f, 0.f, 0.f};
        bf16* xbrow = X1B + (r0 + li) * D + g * 8; unsigned char* xqrow = (dry ? (unsigned char*)(wsl + WS_XP + 96 * MiB) : WSP(unsigned char, WS_X1Q)) + (r0 + li) * D + g * 8;
        const bf16* wrow = rwb + (size_t)li * D + g * 8;
#pragma unroll
        for (int ks = 0; ks < 32; ++ks) {
            const f32x4 xa = {bflo(xr[ks].x), bfhi(xr[ks].x), bflo(xr[ks].y), bfhi(xr[ks].y)}, xb4 = {bflo(xr[ks].z), bfhi(xr[ks].z), bflo(xr[ks].w), bfhi(xr[ks].w)};
            const f32x4 ga = *(const f32x4*)(gamp + ks * 32 + g * 8), gb4 = *(const f32x4*)(gamp + ks * 32 + g * 8 + 4);
            const f32x4 ba = *(const f32x4*)(betp + ks * 32 + g * 8), bb4 = *(const f32x4*)(betp + ks * 32 + g * 8 + 4);
            const bf16x8 wh0 = *(const GAS bf16x8*)(wrow + ks * 32), wh1 = *(const GAS bf16x8*)(wrow + (size_t)16 * D + ks * 32);
            const bf16x8 wl0 = *(const GAS bf16x8*)(wrow + (size_t)NE * D + ks * 32), wl1 = *(const GAS bf16x8*)(wrow + (size_t)NE * D + (size_t)16 * D + ks * 32);
            const f32x4 na = (xa - mean) * rstd * ga + ba, nb = (xb4 - mean) * rstd * gb4 + bb4;
            v4u hw; hw.x = pk2(na[0], na[1]); hw.y = pk2(na[2], na[3]); hw.z = pk2(nb[0], nb[1]); hw.w = pk2(nb[2], nb[3]);
            *(GAS v4u*)(xbrow + ks * 32) = hw;
            { v2u q; q.x = pk4_fp8(na[0] * SC_X8, na[1] * SC_X8, na[2] * SC_X8, na[3] * SC_X8); q.y = pk4_fp8(nb[0] * SC_X8, nb[1] * SC_X8, nb[2] * SC_X8, nb[3] * SC_X8); *(GAS v2u*)(xqrow + ks * 32) = q; }
            v4u lw; lw.x = pk2(na[0] - bflo(hw.x), na[1] - bfhi(hw.x)); lw.y = pk2(na[2] - bflo(hw.y), na[3] - bfhi(hw.y));
                    lw.z = pk2(nb[0] - bflo(hw.z), nb[1] - bfhi(hw.z)); lw.w = pk2(nb[2] - bflo(hw.w), nb[3] - bfhi(hw.w));
            const bf16x8 ah = __builtin_bit_cast(bf16x8, hw), al = __builtin_bit_cast(bf16x8, lw);
            acc0 = mfma16(ah, wh0, acc0); acc1 = mfma16(ah, wh1, acc1);
            acc0 = mfma16(ah, wl0, acc0); acc1 = mfma16(ah, wl1, acc1);
            acc0 = mfma16(al, wh0, acc0); acc1 = mfma16(al, wh1, acc1);
            if (ks & 1) __builtin_amdgcn_sched_barrier(0);
        }
        {
            const float b0 = rbp[li], b1 = rbp[16 + li];
#pragma unroll
            for (int r = 0; r < 4; ++r) { LG[(g * 4 + r) * 32 + li] = acc0[r] + b0; LG[(g * 4 + r) * 32 + 16 + li] = acc1[r] + b1; }
        }
        LDS_WAIT(); asm volatile("" ::: "memory");
        if (lane < 16) {
            float lg[32];
#pragma unroll
            for (int e4 = 0; e4 < 8; ++e4) { const f32x4 t = *(const LAS f32x4*)(LG + lane * 32 + e4 * 4); lg[e4 * 4] = t[0]; lg[e4 * 4 + 1] = t[1]; lg[e4 * 4 + 2] = t[2]; lg[e4 * 4 + 3] = t[3]; }
            int te[4]; float tv[4]; unsigned used = 0u;
#pragma unroll
            for (int k = 0; k < 4; ++k) { float bv = -INFINITY; int be = 0;
#pragma unroll
                for (int e = 0; e < 32; ++e) { const bool ok = !((used >> e) & 1u) && lg[e] > bv; bv = ok ? lg[e] : bv; be = ok ? e : be; }
                te[k] = be; tv[k] = bv; used |= 1u << be; }
            const float e1 = __expf(tv[1] - tv[0]), e2 = __expf(tv[2] - tv[0]), e3 = __expf(tv[3] - tv[0]);
            const float inv = 1.0f / (1.0f + e1 + e2 + e3);
            const float gk[4] = {inv, e1 * inv, e2 * inv, e3 * inv};
            const int rl = w * 16 + lane;
#pragma unroll
            for (int k = 0; k < 4; ++k) { const int lr = atomicAdd((int*)&wcnt[te[k]], 1); rec[(rl * 4 + k) * 3 + 0] = te[k]; rec[(rl * 4 + k) * 3 + 1] = lr; rec[(rl * 4 + k) * 3 + 2] = __float_as_int(gk[k]); }
        }
        __syncthreads();
        if (tid < 32) wbase[tid] = (int)__hip_atomic_fetch_add(F.ctl + CW_CNT + cofs + (F.layer * NE + tid) * 64, (unsigned)wcnt[tid], RLX_AGENT);
        __syncthreads();
        {
            const int rl = tid >> 2, k = tid & 3; const size_t o = ((size_t)rg * 128 + rl) * 4 + k;
            const int e = rec[(rl * 4 + k) * 3 + 0];
            const int rk = wbase[e] + rec[(rl * 4 + k) * 3 + 1];
            TOKO[o] = e; TOKO[131072 + o] = rk; TOKO[3 * 131072 + o] = rec[(rl * 4 + k) * 3 + 2];
            RT2[(size_t)e * RT2_CAP + rk] = (int)(o >> 2);
        }
        __syncthreads();
    }
}
__device__ __forceinline__ void combine_phase(Frame& F, bool last) {
    (void)moe_tables(F);
    const LAS int* off = (const LAS int*)(F.lctl + LC_OFF);
    PH_IDS; float* xout = last ? (float*)(__attribute__((address_space(1))) float*)Al->out : WSP(float, WS_XF); const int gw = bid_ * NWAVES + w, NGW = G_ * NWAVES;
    const bf16* X1Bc = WSP(const bf16, WS_X1B); const bf16* Y = WSP(const bf16, WS_PJ); const int* TOK = WSP(const int, WS_TOK); bf16* XB = WSP(bf16, WS_XB);
    f32x4 gam[4], bet[4];
#pragma unroll
    for (int j = 0; j < 4; ++j) { gam[j] = *(const f32x4*)(LIN(20, 1024) + 4 * (lane + 64 * j)); bet[j] = *(const f32x4*)(LIN(21, 1024) + 4 * (lane + 64 * j)); }
#define CB_LOAD(yv, xv, ii) do { const int row_ = gw + (i0 + (ii)) * NGW; if (row_ < M) { \
        _Pragma("unroll") for (int k = 0; k < 4; ++k) { const int slot_ = __builtin_amdgcn_readlane(slot_l, ((ii) & 15) * 4 + k); \
            _Pragma("unroll") for (int j = 0; j < 4; ++j) yv[k][j] = *(const GAS v2u*)(Y + (size_t)slot_ * D + 4 * (lane + 64 * j)); } \
        _Pragma("unroll") for (int j = 0; j < 4; ++j) xv[j] = *(const GAS v2u*)(X1Bc + (size_t)row_ * D + 4 * (lane + 64 * j)); } } while (0)
#define CB_COMP(yv, xv, ii) do { const int row_ = gw + (i0 + (ii)) * NGW; if (row_ < M) { f32x4 v[4]; \
        _Pragma("unroll") for (int j = 0; j < 4; ++j) v[j] = (f32x4){bflo(xv[j].x), bfhi(xv[j].x), bflo(xv[j].y), bfhi(xv[j].y)} * ALPHA_RES; \
        _Pragma("unroll") for (int k = 0; k < 4; ++k) { const float gk = __int_as_float(__builtin_amdgcn_readlane(gate_l, ((ii) & 15) * 4 + k)); \
            _Pragma("unroll") for (int j = 0; j < 4; ++j) { v[j][0] = fmaf(gk, bflo(yv[k][j].x), v[j][0]); v[j][1] = fmaf(gk, bfhi(yv[k][j].x), v[j][1]); v[j][2] = fmaf(gk, bflo(yv[k][j].y), v[j][2]); v[j][3] = fmaf(gk, bfhi(yv[k][j].y), v[j][3]); } } \
        float s_ = 0.f; _Pragma("unroll") for (int j = 0; j < 4; ++j) s_ += (v[j][0] + v[j][1]) + (v[j][2] + v[j][3]); \
        const float mean_ = wave_sum(s_) * (1.0f / D); float s2_ = 0.f; \
        _Pragma("unroll") for (int j = 0; j < 4; ++j) { v[j] = v[j] - mean_; s2_ += (v[j][0] * v[j][0] + v[j][1] * v[j][1]) + (v[j][2] * v[j][2] + v[j][3] * v[j][3]); } \
        const float rstd_ = 1.0f / sqrtf(wave_sum(s2_) * (1.0f / D) + LN_EPS); \
        _Pragma("unroll") for (int j = 0; j < 4; ++j) { v[j] = v[j] * rstd_ * gam[j] + bet[j]; \
            if (last) *(GAS f32x4*)(xout + (size_t)row_ * D + 4 * (lane + 64 * j)) = v[j]; \
            else { v2u o_; o_.x = pk2(v[j][0], v[j][1]); o_.y = pk2(v[j][2], v[j][3]); *(GAS v2u*)(XB + (size_t)row_ * D + 4 * (lane + 64 * j)) = o_; } } } } while (0)
    const int nper = (M + NGW - 1) / NGW;
    for (int i0 = 0; i0 < nper; i0 += 16) {
        int slot_l = 0, gate_l = 0;
        { const int rl = gw + (i0 + (lane >> 2)) * NGW;
          if (i0 + (lane >> 2) < nper && rl < M) { const size_t o = (size_t)rl * 4 + (lane & 3); slot_l = off[TOK[o]] + TOK[131072 + o]; gate_l = TOK[3 * 131072 + o]; } }
        v2u yA[4][4], xA[4], yB[4][4], xB[4];
        CB_LOAD(yA, xA, 0);
#pragma unroll 1
        for (int ii = 0; ii < 16; ii += 2) {
            CB_LOAD(yB, xB, ii + 1); CB_COMP(yA, xA, ii);
            if (ii + 2 < 16) CB_LOAD(yA, xA, ii + 2);
            CB_COMP(yB, xB, ii + 1);
        }
    }
#undef CB_LOAD
#undef CB_COMP
}

constexpr int NPHASE = 1 + 10 * DEPTH;
#if ONE_LAUNCH
#ifndef PROBE_BAR
#define PROBE_BAR 0
#endif
#define GRID_BAR() do { xcd_barrier(bar); if (PROBE_BAR) xcd_barrier(bar); } while (0)
#else
#define GRID_BAR() do { } while (0)
#endif
#ifndef STG_P1
#define STG_P1 0
#define STG_P6 0
#define STG_G1 8
#define STG_G2 20
#endif
#define KIND(k) ((k) == 0 ? 0 : (((k) - 1) % 10) + 1)
#define IN(k) (((PHM >> KIND(k)) & 1) && lo <= (k) && (k) < hi)
#define SEAM(k) do { if (IN(k) && IN((k) + 1)) GRID_BAR(); } while (0)
#ifndef PROBE_DBL
#define PROBE_DBL 0
#endif
#define REPS(kind) for (int rep_ = 0; rep_ < (((PROBE_DBL >> (kind)) & 1) ? 2 : 1); ++rep_)
#ifndef PROBE_X1SUB
#define PROBE_X1SUB 0
#endif
#define SUBREP(k) for (int r2_ = 0; r2_ < ((PROBE_X1SUB == (k)) ? 2 : 1); ++r2_)
#if !ONE_LAUNCH
struct XcdBarrierDummy { int x; };
#endif
template <int PHM, int l, class Bar>
__device__ __forceinline__ void layer_phases(Frame& F, Bar& bar, const int lo, const int hi) {
    (void)bar;
        const int pb = 1 + 10 * l;
        F.layer = l;
        if (IN(pb + 0)) {
            REPS(1) {
            PH_PTRS;
            pg8::StaticOrder S; S.init(WSP(const bf16, WS_XB), WSP(const bf16, WS_WIN) + (size_t)l * NP * D, M, NP, D, G_, bid_);
#ifdef PROBE_EPI
            EpiProj E{WSP(bf16, WS_PJ), WSP(const f32x2, WS_ROPE), rep_};
#else
            EpiProj E{WSP(bf16, WS_PJ), WSP(const f32x2, WS_ROPE)};
#endif
            pg8::gemm_phase<EpiProj, pg8::StaticOrder, true, true, false, STG_P1>(F.lds, D, S, E);
            }
            SEAM(pb + 0);
        }
        if (IN(pb + 1)) {
            REPS(2) {
            PH_PTRS;
            constexpr int N_DS = NB * 256, N_RS = NB * 4 * 32, N_RG = NB * 64, N_KM = NB * 16;
            REPS(12) {
                const int nround = (N_DS + G_ - 1) / G_;
                for (int k = 0; k < nround; ++k) {
                    const int u = k * G_ + ((k & 1) ? (G_ - 1 - bid_) : bid_);
                    if (u >= N_DS) continue;
                    dsa_unit(F, u & 7, 255 - (u >> 3));
                }
            }
            REPS(13) for (int u = bid_; u < N_RS + N_RG + N_KM; u += G_) {
                if (u < N_RS) { SUBREP(1) ret_state_unit(F, u >> 7, (u >> 5) & 3, u & 31); }
                else if (u < N_RS + N_RG) { const int v = u - N_RS; SUBREP(2) rg_local_unit(F, v >> 6, v & 63); }
                else { const int v = u - N_RS - N_RG; SUBREP(3) kmean_unit(F, v >> 4, v & 15); }
            }
            }
            SEAM(pb + 1);
        }
        if (IN(pb + 2)) {
            REPS(11) { ret_prefix(F); rg_carry(F); }
            SEAM(pb + 2);
        }
        if (IN(pb + 3)) {
            REPS(4) {
            PH_PTRS;
            const int nround = (1024 + G_ - 1) / G_;
            REPS(14) for (int k = 0; k < nround; ++k) {
                const int u = k * G_ + ((k & 1) ? (G_ - 1 - bid_) : bid_);
                if (u >= 1024) continue;
                const int qt = 15 - (u >> 6), rem = u & 63, b = (rem & 31) >> 2, h = rem & 3;
                if (rem >> 5) attn_unit<1>(F, b, h, qt); else attn_unit<0>(F, b, h, qt);
            }
            REPS(15) for (int u = bid_; u < 512; u += G_) attn_unit<2>(F, u >> 6, (u >> 4) & 3, u & 15);
            REPS(16) for (int u = bid_; u < 512; u += G_) rg_final_unit(F, u >> 6, u & 63);
            }
            SEAM(pb + 3);
        }
        if (IN(pb + 4)) {
            REPS(5) {
            PH_PTRS;
            pg8::StaticOrder S; S.init(WSP(const bf16, WS_MIX), WSP(const bf16, WS_WOUT) + (size_t)l * D * D, M, D, D, G_, bid_);
            typedef EpiRes ER;
#ifdef PROBE_EPI
            ER E{WSP(const bf16, WS_XB), WSP(bf16, WS_Y1), rep_};
#else
            ER E{WSP(const bf16, WS_XB), WSP(bf16, WS_Y1)};
#endif
            pg8::gemm_phase<ER, pg8::StaticOrder, true, true, false, STG_P6>(F.lds, D, S, E);
            }
            SEAM(pb + 4);
        }
        if (IN(pb + 5)) { if ((PROBE_DBL >> 6) & 1) router_phase(F, true); router_phase(F); if (IN(pb + 7)) GRID_BAR(); }
        if (IN(pb + 7)) {
            REPS(8) {
            const int np = moe_tables(F);
            PH_PTRS;
            pg8::MoeGatherOrder S; S.init(8, np, G_, bid_); S.Ab = (const char*)WSP(const unsigned char, WS_X1Q); S.rowtok = WSP(const int, WS_ROWTOK); S.off = (const LAS int*)(F.lctl + LC_OFF); S.cnt = (const LAS int*)(F.lctl + LC_CNT); S.rowbytes = (unsigned)D; S.Wb = (const char*)(WSP(const unsigned char, WS_W1) + (size_t)l * NE * 2048 * D);
            S.tstep = (size_t)256 * D; S.estride = (size_t)2048 * D; S.ptab = (const LAS int*)(F.lctl + LC_PTAB);
#ifdef PROBE_EPI
            EpiSwiglu E{WSP(unsigned char, WS_G), LIN(17, 65536), (const LAS int*)(F.lctl + LC_PTAB), rep_};
#else
            EpiSwiglu E{WSP(unsigned char, WS_G), LIN(17, 65536), (const LAS int*)(F.lctl + LC_PTAB)};
#endif
            pg8::gemm_phase<EpiSwiglu, pg8::MoeGatherOrder, true, true, true, STG_G1>(F.lds, D / 2, S, E);
            }
            SEAM(pb + 7);
        }
        if (IN(pb + 8)) {
            REPS(9) {
            const int np = moe_tables(F);
            PH_PTRS;
            pg8::MoeOrder S; S.init(4, np, G_, bid_); S.Ab = (const char*)WSP(const unsigned char, WS_G); S.Wb = (const char*)(WSP(const unsigned char, WS_W2) + (size_t)l * NE * D * FF);
            S.tstep = (size_t)256 * FF; S.estride = (size_t)D * FF; S.ptab = (const LAS int*)(F.lctl + LC_PTAB);
#ifdef PROBE_EPI
            EpiBias E{WSP(bf16, WS_PJ), LIN(19, 32768), (const LAS int*)(F.lctl + LC_PTAB), rep_, (bf16*)(wsl + WS_XP + 48 * MiB)};
#else
            EpiBias E{WSP(bf16, WS_PJ), LIN(19, 32768), (const LAS int*)(F.lctl + LC_PTAB)};
#endif
            pg8::gemm_phase<EpiBias, pg8::MoeOrder, true, true, true, STG_G2>(F.lds, FF / 2, S, E);
            }
            SEAM(pb + 8);
        }
        if (IN(pb + 9)) { REPS(10) combine_phase(F, l == DEPTH - 1); SEAM(pb + 9); }
}

template <int PHM> __global__ void __launch_bounds__(NTHR, 2) fwd(Args args) {
    extern __shared__ __attribute__((aligned(16))) unsigned char lds[];
    Frame F;
    F.lds = (LAS unsigned char*)lds; F.lctl = F.lds + LDSCTL_OFF;
    F.G = gridDim.x; F.bid = blockIdx.x; F.ws = args.ws; F.ctl = (gu32*)(args.ws + WS_CTL); F.layer = 0;
    for (int u = threadIdx.x; u < (LDS_BYTES - LDSCTL_OFF) / 4; u += NTHR) ((LAS unsigned*)F.lctl)[u] = 0u;
    __syncthreads();
    const int lo = args.ph_lo, hi = args.ph_hi;
#if ONE_LAUNCH
    XcdBarrier bar = xcd_barrier_post((unsigned*)(F.ctl + CW_BAR), (volatile LAS unsigned*)(F.lctl + LC_MISC));
#else
    XcdBarrierDummy bar{0};
#endif
    if (IN(0)) { REPS(0) p0_prologue(F); SEAM(0); }

    layer_phases<PHM, 0>(F, bar, lo, hi);
    layer_phases<PHM, 1>(F, bar, lo, hi);
    static_assert(DEPTH == 2, "two layer_phases calls");
#undef IN
#undef SEAM
}

typedef void (*KernelFn)(Args);
template <int K> static KernelFn kind_fn() { return fwd<(1 << K)>; }
extern "C" void kernel_launch(void* const* d_in, const int* in_sizes, int n_in, void* d_out, int out_size, void* d_ws, size_t ws_size, hipStream_t stream) {
    static int grid = 0;
#if ONE_LAUNCH
    static KernelFn fns[1] = { fwd<0x7ff> };
    constexpr int NFN = 1;
#else
    static KernelFn fns[11] = { kind_fn<0>(), kind_fn<1>(), kind_fn<2>(), kind_fn<3>(), kind_fn<4>(), kind_fn<5>(), kind_fn<6>(), kind_fn<7>(), kind_fn<8>(), kind_fn<9>(), kind_fn<10>() };
    constexpr int NFN = 11;
#endif
    if (grid == 0) {
        if (n_in != 22 || in_sizes[0] != M * D || out_size != M * D || ws_size < WS_END) {
            fprintf(stderr, "kernel_launch: unexpected shapes (n_in %d, in0 %d, out %d, ws %zu, need %zu); nothing launched\n", n_in, n_in > 0 ? in_sizes[0] : -1, out_size, ws_size, (size_t)WS_END); grid = -1; return; }
        int dev = 0, cus = 0;
        if (hipGetDevice(&dev) != hipSuccess || hipDeviceGetAttribute(&cus, hipDeviceAttributeMultiprocessorCount, dev) != hipSuccess) { fprintf(stderr, "kernel_launch: device query failed\n"); grid = -1; return; }
        for (int i = 0; i < NFN; ++i)
            if (hipFuncSetAttribute((const void*)fns[i], hipFuncAttributeMaxDynamicSharedMemorySize, LDS_BYTES) != hipSuccess) { fprintf(stderr, "kernel_launch: hipFuncSetAttribute failed\n"); grid = -1; return; }
        (void)hipGetLastError();
        grid = cus;
    }
    if (grid < 0) return;
    if (hipMemsetAsync((char*)d_ws + WS_CTL, 0, CTL_ZERO_BYTES, stream) != hipSuccess) { fprintf(stderr, "kernel_launch: memset failed\n"); return; }
    Args a{};
    for (int i = 0; i < 22; ++i) a.in[i] = (const float*)d_in[i];
    a.out = (float*)d_out; a.ws = (unsigned char*)d_ws;
#if ONE_LAUNCH
    a.ph_lo = 0; a.ph_hi = NPHASE;
    hipLaunchKernelGGL(fns[0], dim3(grid), dim3(NTHR), LDS_BYTES, stream, a);
#else
    for (int p = 0; p < NPHASE; ++p) { a.ph_lo = p; a.ph_hi = p + 1; const int kind = (p == 0) ? 0 : ((p - 1) % 10) + 1;
        hipLaunchKernelGGL(fns[kind], dim3(grid), dim3(NTHR), LDS_BYTES, stream, a); }
#endif
}
```

```cpp
#include <hip/hip_runtime.h>
#include <cstdio>
#include <cstdint>

#ifndef ONE_LAUNCH
#define ONE_LAUNCH 1
#endif

namespace pg8 {
#define PG8_LAS __attribute__((address_space(3)))
typedef unsigned short bf16_t;
typedef short bf16x8 __attribute__((ext_vector_type(8)));
typedef float f32x4 __attribute__((ext_vector_type(4)));
typedef unsigned u32x4 __attribute__((ext_vector_type(4)));
constexpr int BM = 256, BK = 64, HALF = 128, HTB = HALF * BK * 2  , STAGE_BYTES = 8 * HTB, NXCD = 8, WGM = 8;

__host__ __device__ __forceinline__ int lds_byte(int r, int c) { const int st = (r >> 4) * 2 + (c >> 5), rr = r & 15, cc = c & 31, ob = rr * 64 + cc * 2; return st * 1024 + (ob ^ (((ob >> 9) & 1) << 5)); }
__host__ __device__ __forceinline__ void stage_rc(int b, int& R, int& C) { const int st = b / 1024, sb = b % 1024, swz = sb ^ (((sb >> 9) & 1) << 5); R = (st >> 1) * 16 + swz / 64; C = (st & 1) * 32 + (swz % 64) / 2; }
__host__ __device__ __forceinline__ int perm32(int rho) { const int n = rho >> 4, i = rho & 15; return 8 * (i >> 2) + 4 * n + (i & 3); }

struct Unit { int pm, pn; };

struct StaticOrder {
    static constexpr bool GATHER = false;
    __device__ __forceinline__ unsigned rowoff(const Unit&, int) const { return 0u; }
    int nM, nN, nwg, G, c; const char* Ab; const char* Bb; size_t tstep;
    __device__ __forceinline__ void init(const void* A, const void* Bt, int M, int N, int K, int G_, int c_) { nM = M / BM; nN = N / BM; nwg = nM * nN; G = G_; c = c_; Ab = (const char*)A; Bb = (const char*)Bt; tstep = (size_t)BM * K * 2; }
    __device__ __forceinline__ bool next(int i, Unit& u) const {
        const long L = (long)i * G + c; if (L >= nwg) return false;
        int wgid = (int)L; { const int q = nwg / NXCD, r = nwg % NXCD, xcd = wgid % NXCD, off = wgid / NXCD; wgid = (xcd < r ? xcd * (q + 1) : r * (q + 1) + (xcd - r) * q) + off; }
        const int nig = WGM * nN, gid = wgid / nig, fm = gid * WGM, gsz = (nM - fm) < WGM ? (nM - fm) : WGM;
        u.pm = fm + ((wgid % nig) % gsz); u.pn = (wgid % nig) / gsz; return true;
    }
    __device__ __forceinline__ const char* A(const Unit& u) const { return Ab + (size_t)u.pm * tstep; }
    __device__ __forceinline__ const char* B(const Unit& u) const { return Bb + (size_t)u.pn * tstep; }
    __device__ __forceinline__ void a_ready(const Unit&) const {}
    __device__ __forceinline__ void done(const Unit&) const {}
    __device__ __forceinline__ int lag() const { return 0; }
};
struct MoeOrder {
    static constexpr bool GATHER = false;
    __device__ __forceinline__ unsigned rowoff(const Unit&, int) const { return 0u; }
    int nN, np, ppx, G, c; const char* Ab; const char* Wb; size_t tstep, estride; const PG8_LAS int* ptab;
    __device__ __forceinline__ void init(int nN_, int np_, int G_, int c_) { nN = nN_; np = np_; G = G_; c = c_; ppx = (np_ + NXCD - 1) / NXCD; }
    __device__ __forceinline__ bool next(int i, Unit& u) const {
        if (G % NXCD != 0) { const long L = (long)i * G + c; if (L >= (long)np * nN) return false; u.pm = (int)L / nN; u.pn = (int)L % nN; return true; }
        const int x = c % NXCD, s = c / NXCD, wpx = G / NXCD, v = i * wpx + s, pl = v / nN;
        const int p0 = x * ppx, pend = (p0 + ppx) < np ? (p0 + ppx) : np;
        if (p0 + pl >= pend) return false;
        u.pm = p0 + pl; u.pn = v % nN; return true;
    }
    __device__ __forceinline__ const char* A(const Unit& u) const { return Ab + (size_t)u.pm * tstep; }
    __device__ __forceinline__ const char* B(const Unit& u) const { const int e = __builtin_amdgcn_readfirstlane(ptab[u.pm]); return Wb + (size_t)e * estride + (size_t)u.pn * tstep; }
    __device__ __forceinline__ void a_ready(const Unit&) const {}
    __device__ __forceinline__ void done(const Unit&) const {}
    __device__ __forceinline__ int lag() const { return (G % NXCD != 0) ? (int)(((long)c * 32) / G) : (int)(((long)(c / NXCD) * 32) / (G / NXCD)); }
};

struct MoeGatherOrder : MoeOrder {
    static constexpr bool GATHER = true;
    const int* rowtok; const PG8_LAS int* off; const PG8_LAS int* cnt; unsigned rowbytes;
    __device__ __forceinline__ const char* A(const Unit&) const { return Ab; }
    __device__ __forceinline__ unsigned rowoff(const Unit& u, int prow) const {
        const int e = __builtin_amdgcn_readfirstlane(ptab[u.pm]); const int valid = __builtin_amdgcn_readfirstlane(cnt[e] - (u.pm * 256 - off[e]));
        const int lrow = __builtin_amdgcn_readfirstlane(u.pm * 256 - off[e]);
        const int tok = (prow < valid) ? rowtok[(size_t)e * 32768 + lrow + prow] : 0;
        return (unsigned)tok * rowbytes;
    }
};

typedef int v8i_t __attribute__((ext_vector_type(8)));
template <class Epi, class Sched, bool ALIGN_EPI = false, bool SP2 = false, bool F8 = false, int STAGGER = 0>
__device__ __forceinline__ void gemm_phase(PG8_LAS unsigned char* lds, const int K, const Sched& S, const Epi& E) {
    int tid_ = threadIdx.x; asm volatile("" : "+v"(tid_)); const int tid = tid_, wid = __builtin_amdgcn_readfirstlane(tid >> 6), lane = tid & 63, wr = wid >> 2, wc = wid & 3, fr = lane & 15, fq = lane >> 4;
    const int nt = K / BK;
    unsigned voffA[2], voffB[2];
    constexpr bool GA = Sched::GATHER;
    int RpA[2]; unsigned CpA[2];
    unsigned cv0[2] = {0u, 0u}, cv1[2] = {0u, 0u}, nv0[2] = {0u, 0u}, nv1[2] = {0u, 0u};
#pragma unroll
    for (int i = 0; i < 2; ++i) { int R, C; stage_rc(tid * 16 + i * 8192, R, C); const int Rb = Epi::BJADJ ? ((R >> 5) * 64 + perm32(R & 31)) : (Epi::PERM ? ((R & ~31) + perm32(R & 31)) : R);
        voffA[i] = (unsigned)(R * K + C) * 2u; voffB[i] = (unsigned)(Rb * K + C) * 2u; RpA[i] = R; CpA[i] = (unsigned)C * 2u; }
    const size_t kstep = (size_t)(BK * 2);
    const size_t hstep = (size_t)HALF * K * 2;
    const size_t hstepB = Epi::BJADJ ? (size_t)32 * K * 2 : hstep;
    const unsigned ldsw = (unsigned)wid * 1024u;
    const int aoff = lds_byte(wr * 64 + fr, fq * 8);
    const int boff = lds_byte(wc * 32 + fr, fq * 8);
    int f8sc = 0x7f7f7f7f; (void)f8sc;
#define PG8_SA(b, h) (((b) * 2 + (h)) * HTB)
#define PG8_SB(b, h) ((4 + (b) * 2 + (h)) * HTB)
#define PG8_STAGE(bufoff, gbase, voff) do { _Pragma("unroll") for (int _i = 0; _i < 2; ++_i) \
        __builtin_amdgcn_global_load_lds((const unsigned*)((const char*)(gbase) + (voff)[_i]), (PG8_LAS unsigned*)(lds + (bufoff) + ldsw + _i * 8192), 16, 0, 0); } while (0)
#define PG8_STA(bufoff, base, half, V0, V1) do { if constexpr (GA) { if (half) PG8_STAGE(bufoff, base, V1); else PG8_STAGE(bufoff, base, V0); } else { PG8_STAGE(bufoff, (base) + ((half) ? hstep : 0), voffA); } } while (0)
#define PG8_GAOFF(u, D0, D1) do { _Pragma("unroll") for (int _i = 0; _i < 2; ++_i) { D0[_i] = S.rowoff(u, RpA[_i]) + CpA[_i]; D1[_i] = S.rowoff(u, HALF + RpA[_i]) + CpA[_i]; } } while (0)
#define PG8_LDA(dst, b, h) do { if constexpr (F8) { _Pragma("unroll") for (int m = 0; m < 4; ++m) { const u32x4 lo_ = *(const PG8_LAS u32x4*)(lds + PG8_SA(b, h) + aoff + m * 2048), hi_ = *(const PG8_LAS u32x4*)(lds + PG8_SA(b, h) + aoff + m * 2048 + 1024); dst##8[m] = (v8i_t){(int)lo_.x, (int)lo_.y, (int)lo_.z, (int)lo_.w, (int)hi_.x, (int)hi_.y, (int)hi_.z, (int)hi_.w}; } } else { _Pragma("unroll") for (int m = 0; m < 4; ++m) _Pragma("unroll") for (int k = 0; k < 2; ++k) dst[m][k] = *(const PG8_LAS bf16x8*)(lds + PG8_SA(b, h) + aoff + m * 2048 + k * 1024); } } while (0)
#define PG8_LDB(dst, b, h) do { if constexpr (F8) { _Pragma("unroll") for (int n = 0; n < 2; ++n) { const u32x4 lo_ = *(const PG8_LAS u32x4*)(lds + PG8_SB(b, h) + boff + n * 2048), hi_ = *(const PG8_LAS u32x4*)(lds + PG8_SB(b, h) + boff + n * 2048 + 1024); dst##8[n] = (v8i_t){(int)lo_.x, (int)lo_.y, (int)lo_.z, (int)lo_.w, (int)hi_.x, (int)hi_.y, (int)hi_.z, (int)hi_.w}; } } else { _Pragma("unroll") for (int n = 0; n < 2; ++n) _Pragma("unroll") for (int k = 0; k < 2; ++k) dst[n][k] = *(const PG8_LAS bf16x8*)(lds + PG8_SB(b, h) + boff + n * 2048 + k * 1024); } } while (0)
#define PG8_MMA(ai, bj, At, Bt) do { __builtin_amdgcn_s_setprio(1); if constexpr (F8) { _Pragma("unroll") for (int m = 0; m < 4; ++m) _Pragma("unroll") for (int n = 0; n < 2; ++n) \
        asm volatile("v_mfma_scale_f32_16x16x128_f8f6f4 %0, %1, %2, %0, %3, %3 op_sel_hi:[0,0,0]" : "+v"(acc[ai][bj][m][n]) : "v"(Bt##8[n]), "v"(At##8[m]), "v"(f8sc)); } \
        else { _Pragma("unroll") for (int m = 0; m < 4; ++m) _Pragma("unroll") for (int n = 0; n < 2; ++n) _Pragma("unroll") for (int k = 0; k < 2; ++k) \
        acc[ai][bj][m][n] = __builtin_amdgcn_mfma_f32_16x16x32_bf16(Bt[n][k], At[m][k], acc[ai][bj][m][n], 0, 0, 0); } __builtin_amdgcn_s_setprio(0); } while (0)
#define PG8_WAIT_V(n) asm volatile("s_waitcnt vmcnt(" #n ")" ::: "memory")
#define PG8_WAIT_L(n) asm volatile("s_waitcnt lgkmcnt(" #n ")" ::: "memory")
#define PG8_BAR __builtin_amdgcn_s_barrier()
#define PG8_SCHED __builtin_amdgcn_sched_barrier(0)
    Unit cur, nxt; int ui = 0;
    if (!S.next(0, cur)) return;
    if constexpr (STAGGER > 0) { const int lg_ = __builtin_amdgcn_readfirstlane(S.lag()); for (int q = 0; q < lg_; ++q) __builtin_amdgcn_s_sleep(STAGGER); }
    f32x4 acc[2][2][4][2];
#pragma unroll
    for (int a = 0; a < 2; ++a)
#pragma unroll
        for (int b = 0; b < 2; ++b)
#pragma unroll
            for (int m = 0; m < 4; ++m)
#pragma unroll
                for (int n = 0; n < 2; ++n) acc[a][b][m][n] = (f32x4){0.f, 0.f, 0.f, 0.f};
    if constexpr (F8) { PG8_SCHED; asm volatile("s_nop 7" ::: "memory"); PG8_SCHED; }
    bf16x8 At[4][2], B0[2][2], B1[2][2];
    v8i_t At8[4], B08[2], B18[2];
    const char* cA = S.A(cur); const char* cB = S.B(cur);
    if constexpr (GA) PG8_GAOFF(cur, cv0, cv1);
    S.a_ready(cur);
    if constexpr (SP2) {
        PG8_STAGE(PG8_SB(0, 0), cB, voffB); PG8_STAGE(PG8_SB(0, 1), cB + hstepB, voffB); PG8_STA(PG8_SA(0, 0), cA, 0, cv0, cv1); PG8_STA(PG8_SA(0, 1), cA, 1, cv0, cv1);
        if (wr == 1) PG8_BAR;
        PG8_WAIT_V(2); PG8_BAR;
        PG8_STAGE(PG8_SB(1, 0), cB + kstep, voffB); PG8_STA(PG8_SA(1, 0), cA + kstep, 0, cv0, cv1); PG8_STAGE(PG8_SB(1, 1), cB + hstepB + kstep, voffB);
        PG8_WAIT_V(6); PG8_BAR;
    } else {
        PG8_STAGE(PG8_SB(0, 0), cB, voffB); PG8_STAGE(PG8_SA(0, 0), cA, voffA); PG8_STAGE(PG8_SB(0, 1), cB + hstepB, voffB); PG8_STAGE(PG8_SA(0, 1), cA + hstep, voffA);
        if (wr == 1) PG8_BAR;
        PG8_WAIT_V(4); PG8_BAR;
        PG8_STAGE(PG8_SB(1, 0), cB + kstep, voffB); PG8_STAGE(PG8_SA(1, 0), cA + kstep, voffA); PG8_STAGE(PG8_SB(1, 1), cB + hstepB + kstep, voffB);
        PG8_WAIT_V(6); PG8_BAR;
    }
    for (;;) {
        const bool has_next = S.next(ui + 1, nxt);
        const char* nA = has_next ? S.A(nxt) : cA; const char* nB = has_next ? S.B(nxt) : cB;
        if constexpr (GA) { if (has_next) PG8_GAOFF(nxt, nv0, nv1); else { nv0[0] = cv0[0]; nv0[1] = cv0[1]; nv1[0] = cv1[0]; nv1[1] = cv1[1]; } }
#pragma unroll 1
        for (int t = 0; t < nt; t += 2) {
            const bool last = (t == nt - 2);
            const char* a1 = cA + (size_t)(t + 1) * kstep;
            const char* a2 = last ? nA : cA + (size_t)(t + 2) * kstep; const char* b2 = last ? nB : cB + (size_t)(t + 2) * kstep;
            const char* a3 = a2 + kstep; const char* b3 = b2 + kstep;
            if (last && has_next) S.a_ready(nxt);
            unsigned sv0[2] = {0u, 0u}, sv1[2] = {0u, 0u};
            if constexpr (GA) { sv0[0] = last ? nv0[0] : cv0[0]; sv0[1] = last ? nv0[1] : cv0[1]; sv1[0] = last ? nv1[0] : cv1[0]; sv1[1] = last ? nv1[1] : cv1[1]; }
            if constexpr (SP2) {
            PG8_LDB(B0, 0, 0); PG8_LDB(B1, 0, 1); PG8_SCHED; PG8_LDA(At, 0, 0); PG8_STA(PG8_SA(1, 1), a1, 1, cv0, cv1);
            PG8_WAIT_V(8); PG8_WAIT_L(0); PG8_BAR; PG8_MMA(0, 0, At, B0); PG8_MMA(0, 1, At, B1); PG8_BAR; PG8_SCHED;
            PG8_LDA(At, 0, 1); PG8_STAGE(PG8_SB(0, 0), b2, voffB); PG8_STAGE(PG8_SB(0, 1), b2 + hstepB, voffB); PG8_STA(PG8_SA(0, 0), a2, 0, sv0, sv1);
            PG8_WAIT_V(8); PG8_WAIT_L(0); PG8_BAR; PG8_MMA(1, 0, At, B0); PG8_MMA(1, 1, At, B1); PG8_BAR; PG8_SCHED;
            PG8_LDB(B0, 1, 0); PG8_LDB(B1, 1, 1); PG8_SCHED; PG8_LDA(At, 1, 0); PG8_STA(PG8_SA(0, 1), a2, 1, sv0, sv1);
            PG8_WAIT_V(8); PG8_WAIT_L(0); PG8_BAR; PG8_MMA(0, 0, At, B0); PG8_MMA(0, 1, At, B1); PG8_BAR; PG8_SCHED;
            PG8_LDA(At, 1, 1); PG8_STAGE(PG8_SB(1, 0), b3, voffB); PG8_STAGE(PG8_SB(1, 1), b3 + hstepB, voffB); PG8_STA(PG8_SA(1, 0), a3, 0, sv0, sv1);
            PG8_WAIT_V(8); PG8_WAIT_L(0); PG8_BAR; PG8_MMA(1, 0, At, B0); PG8_MMA(1, 1, At, B1); PG8_BAR; PG8_SCHED;
            } else {
            PG8_LDB(B0, 0, 0); PG8_SCHED; PG8_LDA(At, 0, 0); PG8_STAGE(PG8_SA(1, 1), a1 + hstep, voffA);
            PG8_WAIT_L(8); PG8_BAR; PG8_WAIT_L(0); PG8_MMA(0, 0, At, B0); PG8_BAR; PG8_SCHED;
            PG8_LDB(B1, 0, 1); PG8_STAGE(PG8_SB(0, 0), b2, voffB);
            PG8_BAR; PG8_WAIT_L(0); PG8_MMA(0, 1, At, B1); PG8_BAR;
            PG8_LDA(At, 0, 1); PG8_STAGE(PG8_SA(0, 0), a2, voffA);
            PG8_BAR; PG8_WAIT_L(0); PG8_MMA(1, 0, At, B0); PG8_BAR; PG8_SCHED;
            PG8_STAGE(PG8_SB(0, 1), b2 + hstepB, voffB);
            PG8_WAIT_V(6); PG8_BAR; PG8_MMA(1, 1, At, B1); PG8_BAR;
            PG8_LDB(B0, 1, 0); PG8_SCHED; PG8_LDA(At, 1, 0); PG8_STAGE(PG8_SA(0, 1), a2 + hstep, voffA);
            PG8_WAIT_L(8); PG8_BAR; PG8_WAIT_L(0); PG8_MMA(0, 0, At, B0); PG8_BAR; PG8_SCHED;
            PG8_LDB(B1, 1, 1); PG8_STAGE(PG8_SB(1, 0), b3, voffB);
            PG8_BAR; PG8_WAIT_L(0); PG8_MMA(0, 1, At, B1); PG8_BAR;
            PG8_LDA(At, 1, 1); PG8_STAGE(PG8_SA(1, 0), a3, voffA);
            PG8_BAR; PG8_WAIT_L(0); PG8_MMA(1, 0, At, B0); PG8_BAR; PG8_SCHED;
            PG8_STAGE(PG8_SB(1, 1), b3 + hstepB, voffB);
            PG8_WAIT_V(6); PG8_BAR; PG8_MMA(1, 1, At, B1); PG8_BAR;
            }
        }
        if constexpr (F8) { PG8_SCHED; asm volatile("s_nop 15\n\ts_nop 15" ::: "memory"); PG8_SCHED; }
        if constexpr (ALIGN_EPI) { if (wr == 0) PG8_BAR; }
        if constexpr (!Epi::AFTER_DRAIN) { E(acc, cur, wr, wc, fr, fq); S.done(cur); }
        if (!has_next) break;
#pragma unroll
        for (int a = 0; a < 2; ++a)
#pragma unroll
            for (int b = 0; b < 2; ++b)
#pragma unroll
                for (int m = 0; m < 4; ++m)
#pragma unroll
                    for (int n = 0; n < 2; ++n) acc[a][b][m][n] = (f32x4){0.f, 0.f, 0.f, 0.f};
        if constexpr (F8) { PG8_SCHED; asm volatile("s_nop 7" ::: "memory"); PG8_SCHED; }
        cur = nxt; cA = nA; cB = nB; ++ui;
        if constexpr (GA) { cv0[0] = nv0[0]; cv0[1] = nv0[1]; cv1[0] = nv1[0]; cv1[1] = nv1[1]; }
        if constexpr (ALIGN_EPI) { if (wr == 1) PG8_BAR; }
    }
    PG8_WAIT_V(0);
    if constexpr (!ALIGN_EPI) { if (wr == 0) PG8_BAR; }
    PG8_BAR;
    if constexpr (Epi::AFTER_DRAIN) { E.fused(acc, cur, wr, wc, fr, fq, lds, wid, lane); S.done(cur); }
#undef PG8_SA
#undef PG8_SB
#undef PG8_STAGE
#undef PG8_STA
#undef PG8_GAOFF
#undef PG8_LDA
#undef PG8_LDB
#undef PG8_MMA
#undef PG8_WAIT_V
#undef PG8_WAIT_L
#undef PG8_BAR
#undef PG8_SCHED
}
}

constexpr int NWAVES = 8, NTHR = 512;
constexpr int NB = 8, T = 4096, D = 1024, M = NB * T, DEPTH = 2;
constexpr int INW = 3656, NP = 3840;
constexpr int NE = 32, FF = 1024;
constexpr float LN_EPS = 1e-5f, ALPHA_RES = 1.41421356237f;
constexpr int C_AQ = 0, C_AK = 256, C_AV = 512, C_RQ = 768, C_RK = 1024, C_RV = 1280, C_RG = 1536, C_CX = 1792, C_CG = 2048, C_DQ = 2304, C_DK = 2560, C_DV = 2816, C_QI = 3072, C_KI = 3584, C_W = 3648;
constexpr int MAXPANELS = 544;
constexpr int MAXROWS = MAXPANELS * 256;

constexpr size_t MiB = 1u << 20;
constexpr size_t WS_CTL = 0, CTL_ZERO_BYTES = 1 * MiB;
constexpr size_t WS_WIN = 1 * MiB;
constexpr size_t WS_WOUT = WS_WIN + 15 * MiB;
constexpr size_t WS_W1 = WS_WOUT + 4 * MiB;
constexpr size_t WS_W2 = WS_W1 + 256 * MiB;
constexpr size_t WS_ROPE = WS_W2 + 128 * MiB;
constexpr size_t WS_XB = WS_ROPE + 1 * MiB;
constexpr size_t WS_XF = WS_XB + 64 * MiB;
constexpr size_t WS_Y1 = WS_XF + 128 * MiB;
constexpr size_t WS_X1B = WS_Y1 + 128 * MiB;
constexpr size_t WS_MIX = WS_X1B + 64 * MiB;
constexpr size_t WS_PJ = WS_MIX + 64 * MiB;
constexpr size_t WS_SC = WS_PJ + 272 * MiB;
constexpr size_t WS_XP = WS_SC, WS_G = WS_SC + 272 * MiB;
constexpr size_t WS_ROWTOK = WS_XP;
constexpr size_t WS_X1Q = WS_XP + 8 * MiB;
constexpr int RT2_CAP = 32768;
constexpr size_t WS_MASK = WS_SC + 544 * MiB;
constexpr size_t WS_HLOC = WS_MASK + 16 * MiB;
constexpr size_t WS_PC = WS_HLOC + 32 * MiB;
constexpr size_t WS_RGS = WS_PC + 32 * MiB;
constexpr size_t WS_ST = WS_RGS + 2 * MiB;
constexpr size_t WS_RT = WS_ST + 16 * MiB;
constexpr size_t WS_KMB = WS_RT + 8 * MiB;
constexpr size_t WS_KN2 = WS_KMB + 256 * 1024;
constexpr size_t WS_RWB = WS_KMB + 512 * 1024;
constexpr size_t WS_RGW = WS_KMB + 768 * 1024;
constexpr size_t WS_TOK = WS_KMB + 1 * MiB;
constexpr size_t WS_END = WS_TOK + 2 * MiB;
static_assert(WS_END <= (size_t)2048 * MiB, "d_ws map exceeds 2 GiB");
constexpr int CW_BAR = 4096;
constexpr int CW_CNT = 16384;

constexpr int RING_BYTES = 131072;
constexpr int LDSCTL_OFF = RING_BYTES;
constexpr int LC_MISC = 0;
constexpr int LC_OFF = 256;
constexpr int LC_CNT = 2816;
constexpr int LC_PTAB = 512;
constexpr int LC_WCNT = 3072;
constexpr int LC_HIST = 4096;
constexpr int LC_REC = 4096;
constexpr int LDS_BYTES = 147456;

#define GAS __attribute__((address_space(1)))
#define LAS __attribute__((address_space(3)))
typedef unsigned short bf16;
typedef unsigned v4u __attribute__((ext_vector_type(4)));
typedef unsigned v2u __attribute__((ext_vector_type(2)));
typedef float f32x4 __attribute__((ext_vector_type(4)));
typedef float f32x2 __attribute__((ext_vector_type(2)));
typedef float f32x16 __attribute__((ext_vector_type(16)));
typedef short bf16x8 __attribute__((ext_vector_type(8)));
typedef GAS unsigned gu32;
#define RLX_AGENT __ATOMIC_RELAXED, __HIP_MEMORY_SCOPE_AGENT
#define LDS_WAIT() asm volatile("s_waitcnt lgkmcnt(0)" ::: "memory")
#define VM_WAIT() asm volatile("s_waitcnt vmcnt(0)" ::: "memory")
__device__ __forceinline__ float bf2f(bf16 b) { return __uint_as_float((unsigned)b << 16); }
__device__ __forceinline__ float bflo(unsigned w) { return __uint_as_float(w << 16); }
__device__ __forceinline__ float bfhi(unsigned w) { return __uint_as_float(w & 0xffff0000u); }
typedef float f32x2_cv __attribute__((ext_vector_type(2)));
typedef __bf16 bf16x2_cv __attribute__((ext_vector_type(2)));
__device__ __forceinline__ unsigned pk2(float lo, float hi) { const f32x2_cv v = {lo, hi}; const bf16x2_cv b = __builtin_convertvector(v, bf16x2_cv); return __builtin_bit_cast(unsigned, b); }
__device__ __forceinline__ float wave_sum(float v) {
#pragma unroll
    for (int o = 1; o < 64; o <<= 1) v += __shfl_xor(v, o);
    return v;
}
__device__ __forceinline__ int wave_sum_i(int v) {
#pragma unroll
    for (int o = 1; o < 64; o <<= 1) v += __shfl_xor(v, o);
    return v;
}
__device__ __forceinline__ int wave_prefix_incl(int x) {
    x += __builtin_amdgcn_update_dpp(0, x, 0x111, 0xf, 0xf, true);
    x += __builtin_amdgcn_update_dpp(0, x, 0x112, 0xf, 0xf, true);
    x += __builtin_amdgcn_update_dpp(0, x, 0x114, 0xf, 0xf, true);
    x += __builtin_amdgcn_update_dpp(0, x, 0x118, 0xf, 0xf, true);
    x += __builtin_amdgcn_update_dpp(0, x, 0x142, 0xa, 0xf, false);
    x += __builtin_amdgcn_update_dpp(0, x, 0x143, 0xc, 0xf, false);
    return x;
}
constexpr float SC_X8 = 16.0f, SC_W8 = 2048.0f, SC_G8 = 4.0f, SC_M8 = 16.0f;
#ifndef P6_F8
#define P6_F8 0
#endif
__device__ __forceinline__ float sat8(float x) { return fminf(fmaxf(x, -448.0f), 448.0f); }
__device__ __forceinline__ unsigned pk4_fp8(float a, float b, float c, float d) { int p = __builtin_amdgcn_cvt_pk_fp8_f32(sat8(a), sat8(b), 0, false); p = __builtin_amdgcn_cvt_pk_fp8_f32(sat8(c), sat8(d), p, true); return (unsigned)p; }
__device__ __forceinline__ f32x4 mfma16(bf16x8 a, bf16x8 b, f32x4 c) { return __builtin_amdgcn_mfma_f32_16x16x32_bf16(a, b, c, 0, 0, 0); }
__device__ __forceinline__ float sigmoidf_(float x) { return __builtin_amdgcn_rcpf(1.f + __builtin_amdgcn_exp2f(-1.4426950408889634f * x)); }
#define XB_TMO      128
#define XB_XCNT(j)  (256  + 64 * (j))
#define XB_XSUB(j)  (1280 + 64 * (j))
#define XB_XGEN(j)  (2304 + 64 * (j))
#define XB_TOP      3328
#define XB_TOPGEN   3392
#define XCD_BAR_WORDS 3456
#define XB_SPIN_CAP (1u << 18)

__device__ __forceinline__ unsigned xb_ld(unsigned* p)              { return __hip_atomic_load(p, __ATOMIC_RELAXED, __HIP_MEMORY_SCOPE_AGENT); }
__device__ __forceinline__ unsigned xb_add(unsigned* p, unsigned v) { return __hip_atomic_fetch_add(p, v, __ATOMIC_RELAXED, __HIP_MEMORY_SCOPE_AGENT); }
__device__ __forceinline__ unsigned xb_xcc_id() { return (unsigned)__builtin_amdgcn_s_getreg((3 << 11) | 20) & 0xFu; }
#define XB_SPIN(cond, bar) do { unsigned _sp = 0; while (cond) { __builtin_amdgcn_s_sleep(1); \
    if ((++_sp & 255u) == 0u) { if (xb_ld(&(bar)[XB_TMO])) break; if (_sp > XB_SPIN_CAP) { atomicAdd(&(bar)[XB_TMO], 1u); break; } } } } while (0)

struct XcdBarrier {
    unsigned* bar; unsigned x;
    volatile LAS unsigned* st;
};

__device__ __forceinline__ XcdBarrier xcd_barrier_post(unsigned* bar, volatile LAS unsigned* st) {
    XcdBarrier b; b.bar = bar; b.x = xb_xcc_id(); b.st = st;
    if (threadIdx.x == 0) (void)xb_add(&bar[XB_XCNT(b.x)], 1u);
    return b;
}
__device__ __forceinline__ void xcd_barrier_complete(unsigned* bar, unsigned x, unsigned& nloc, unsigned& nx) {
    const unsigned G = gridDim.x * gridDim.y * gridDim.z;
    unsigned sum, cnt, mine, sp = 0u;
    for (;;) {
        sum = 0u; cnt = 0u; mine = 0u;
#pragma unroll
        for (unsigned j = 0; j < 16; ++j) { const unsigned c = xb_ld(&bar[XB_XCNT(j)]); sum += c; cnt += (c > 0u) ? 1u : 0u; mine = (j == x) ? c : mine; }
        if (sum == G) break;
        __builtin_amdgcn_s_sleep(1);
        if ((++sp & 255u) == 0u) { if (xb_ld(&bar[XB_TMO])) break; if (sp > XB_SPIN_CAP) { atomicAdd(&bar[XB_TMO], 1u); break; } }
    }
    nloc = mine > 0u ? mine : 1u; nx = cnt > 0u ? cnt : 1u;
}

__device__ __forceinline__ void xcd_barrier(const XcdBarrier& b) {
    asm volatile("s_waitcnt vmcnt(0)" ::: "memory");
    __syncthreads();
    if (threadIdx.x == 0) {
        unsigned* bar = b.bar;
        __builtin_amdgcn_s_waitcnt(0);
        unsigned nloc = b.st[0], nx = b.st[1];
        if (nloc == 0u) { xcd_barrier_complete(bar, b.x, nloc, nx); b.st[0] = nloc; b.st[1] = nx; }
        const unsigned old = xb_add(&bar[XB_XSUB(b.x)], 1u);
        const unsigned gen = old / nloc;
        if (old + 1u == (gen + 1u) * nloc) {
            __builtin_amdgcn_fence(__ATOMIC_RELEASE, "agent");
            asm volatile("s_waitcnt vmcnt(0)" ::: "memory");
            const unsigned og = xb_add(&bar[XB_TOP], 1u);
            const unsigned tg = og / nx;
            if (og + 1u == (tg + 1u) * nx) xb_add(&bar[XB_TOPGEN], 1u);
            else XB_SPIN(xb_ld(&bar[XB_TOPGEN]) == tg, bar);
            __builtin_amdgcn_fence(__ATOMIC_ACQUIRE, "agent");
            xb_add(&bar[XB_XGEN(b.x)], 1u);
            asm volatile("s_waitcnt vmcnt(0)" ::: "memory");
        } else {
            XB_SPIN(xb_ld(&bar[XB_XGEN(b.x)]) == gen, bar);
            __builtin_amdgcn_fence(__ATOMIC_ACQUIRE, "agent");
            asm volatile("s_waitcnt vmcnt(0)" ::: "memory");
        }
    }
    __syncthreads();
}

struct Args { const float* in[22]; float* out; unsigned char* ws; int ph_lo, ph_hi; };
struct Frame {
    LAS unsigned char* lds;
    LAS unsigned char* lctl;
    gu32* ctl;
    unsigned char* ws;
    int G, bid, layer;
};
__device__ __forceinline__ int ltid() { int t = threadIdx.x; asm volatile("" : "+v"(t)); return t; }
__device__ __forceinline__ const void* launder_uniform(const void* p) {
    unsigned lo = (unsigned)(unsigned long long)p, hi = (unsigned)((unsigned long long)p >> 32);
    asm volatile("" : "+v"(lo), "+v"(hi));
    lo = __builtin_amdgcn_readfirstlane(lo); hi = __builtin_amdgcn_readfirstlane(hi);
    return (const void*)(const __attribute__((address_space(1))) char*)(((unsigned long long)hi << 32) | lo);
}
typedef const __attribute__((address_space(4))) Args* KArgs;
__device__ __forceinline__ KArgs launder_kargs() {
    const unsigned long long p = (unsigned long long)__builtin_amdgcn_kernarg_segment_ptr();
    unsigned lo = (unsigned)p, hi = (unsigned)(p >> 32);
    asm volatile("" : "+v"(lo), "+v"(hi));
    lo = __builtin_amdgcn_readfirstlane(lo); hi = __builtin_amdgcn_readfirstlane(hi);
    return (KArgs)(((unsigned long long)hi << 32) | lo);
}
__device__ __forceinline__ int launder_i(int x) { asm volatile("" : "+v"(x)); return __builtin_amdgcn_readfirstlane(x); }
#define PH_PTRS unsigned char* wsl = (unsigned char*)launder_uniform(F.ws); KArgs Al = launder_kargs(); const int G_ = launder_i(F.G), bid_ = launder_i(F.bid); (void)Al; (void)G_; (void)bid_; (void)wsl
#define PH_IDS PH_PTRS; const int tid = ltid(), lane = tid & 63, w = __builtin_amdgcn_readfirstlane(tid >> 6); (void)lane; (void)w
#define LIN(i, stride) ((const float*)((const __attribute__((address_space(1))) float*)Al->in[i] + (size_t)F.layer * (stride)))
#define WSP(T_, off) ((T_*)(wsl + (off)))

struct EpiProj {
    static constexpr bool PERM = true, AFTER_DRAIN = false, BJADJ = false;
    bf16* O; const f32x2* cs;
#ifdef PROBE_EPI
    int skip;
#endif
    __device__ __forceinline__ void operator()(const pg8::f32x4 (&acc)[2][2][4][2], const pg8::Unit& u, int wr, int wc, int fr, int fq) const {
#ifdef PROBE_EPI
        if (skip) { if (acc[0][0][0][0][0] == 1.2345e-30f) O[0] = 0; return; }
#endif
        const int row0 = u.pm * 256 + wr * 64 + fr;
        const int colb = u.pn * 256 + wc * 32 + 8 * fq;
        const int i0 = (colb & 63) >> 1;
        const int colw = __builtin_amdgcn_readfirstlane(u.pn * 256 + wc * 32);
        bool ropeb[2]; float scb[2];
#pragma unroll
        for (int bj = 0; bj < 2; ++bj) { const int c0 = colw + bj * 128;
            ropeb[bj] = (c0 < 512) || (c0 >= 768 && c0 < 1280) || (c0 >= 2304 && c0 < 2816) || (c0 >= 3072 && c0 < 3648);
            scb[bj] = ((c0 < 256) || (c0 >= 2304 && c0 < 2560)) ? 0.18033688011112042f   : ((c0 >= 1024 && c0 < 1280) ? 0.125f : 1.0f); }
        f32x4 c01[2][4], c23[2][4];
        if (ropeb[0] || ropeb[1]) {
#pragma unroll
            for (int ai = 0; ai < 2; ++ai)
#pragma unroll
                for (int m = 0; m < 4; ++m) { const f32x4* cp = (const f32x4*)(cs + (size_t)((row0 + ai * 128 + m * 16) & (T - 1)) * 32 + i0); c01[ai][m] = cp[0]; c23[ai][m] = cp[1]; }
        }
#pragma unroll
        for (int bj = 0; bj < 2; ++bj) {
            const int col0 = colb + bj * 128;
            const float sc = scb[bj];
            if (ropeb[bj]) {
#pragma unroll
                for (int ai = 0; ai < 2; ++ai)
#pragma unroll
                    for (int m = 0; m < 4; ++m) {
                        const int row = row0 + ai * 128 + m * 16;
                        const pg8::f32x4 v0 = acc[ai][bj][m][0], v1 = acc[ai][bj][m][1];
                        const f32x4 ca = c01[ai][m] * sc, cb = c23[ai][m] * sc;
                        pg8::f32x4 o0, o1;
                        o0[0] = v0[0] * ca[0] - v0[1] * ca[1]; o0[1] = v0[1] * ca[0] + v0[0] * ca[1];
                        o0[2] = v0[2] * ca[2] - v0[3] * ca[3]; o0[3] = v0[3] * ca[2] + v0[2] * ca[3];
                        o1[0] = v1[0] * cb[0] - v1[1] * cb[1]; o1[1] = v1[1] * cb[0] + v1[0] * cb[1];
                        o1[2] = v1[2] * cb[2] - v1[3] * cb[3]; o1[3] = v1[3] * cb[2] + v1[2] * cb[3];
                        pg8::u32x4 w; w.x = pk2(o0[0], o0[1]); w.y = pk2(o0[2], o0[3]); w.z = pk2(o1[0], o1[1]); w.w = pk2(o1[2], o1[3]);
                        *(pg8::u32x4*)(O + (size_t)row * NP + col0) = w;
                    }
            } else {
#pragma unroll
                for (int ai = 0; ai < 2; ++ai)
#pragma unroll
                    for (int m = 0; m < 4; ++m) {
                        const int row = row0 + ai * 128 + m * 16;
                        const pg8::f32x4 v0 = acc[ai][bj][m][0] * sc, v1 = acc[ai][bj][m][1] * sc;
                        pg8::u32x4 w; w.x = pk2(v0[0], v0[1]); w.y = pk2(v0[2], v0[3]); w.z = pk2(v1[0], v1[1]); w.w = pk2(v1[2], v1[3]);
                        *(pg8::u32x4*)(O + (size_t)row * NP + col0) = w;
                    }
            }
        }
    }
};
struct EpiRes {
    static constexpr bool PERM = true, AFTER_DRAIN = false, BJADJ = true;
    const bf16* X; bf16* Y;
#ifdef PROBE_EPI
    int skip;
#endif
    __device__ __forceinline__ void operator()(const pg8::f32x4 (&acc)[2][2][4][2], const pg8::Unit& u, int wr, int wc, int fr, int fq) const {
#ifdef PROBE_EPI
        if (skip) { if (acc[0][0][0][0][0] == 1.2345e-30f) Y[0] = 0; return; }
#endif
        const int row0 = u.pm * 256 + wr * 64 + fr;
        const int colb = u.pn * 256 + wc * 64 + 8 * fq;
        v4u xh[2][4][2];
#pragma unroll
        for (int ai = 0; ai < 2; ++ai)
#pragma unroll
            for (int m = 0; m < 4; ++m)
#pragma unroll
                for (int bj = 0; bj < 2; ++bj) xh[ai][m][bj] = *(const v4u*)(X + (size_t)(row0 + ai * 128 + m * 16) * D + colb + bj * 32);
#pragma unroll
        for (int ai = 0; ai < 2; ++ai)
#pragma unroll
            for (int m = 0; m < 4; ++m)
#pragma unroll
                for (int bj = 0; bj < 2; ++bj) { bf16* yp = Y + (size_t)(row0 + ai * 128 + m * 16) * D + colb + bj * 32;
                    const v4u h = xh[ai][m][bj];
                    const f32x4 x0 = {bflo(h.x), bfhi(h.x), bflo(h.y), bfhi(h.y)}, x1 = {bflo(h.z), bfhi(h.z), bflo(h.w), bfhi(h.w)};
                    constexpr float DQ = P6_F8 ? 1.0f / (SC_M8 * SC_W8) : 1.0f;
                    const f32x4 v0 = x0 * ALPHA_RES + acc[ai][bj][m][0] * DQ, v1 = x1 * ALPHA_RES + acc[ai][bj][m][1] * DQ;
                    pg8::u32x4 wv; wv.x = pk2(v0[0], v0[1]); wv.y = pk2(v0[2], v0[3]); wv.z = pk2(v1[0], v1[1]); wv.w = pk2(v1[2], v1[3]);
                    *(pg8::u32x4*)yp = wv; }
    }
};
struct EpiSwiglu {
    static constexpr bool PERM = true, AFTER_DRAIN = false, BJADJ = false;
    unsigned char* Gm; const float* b1; const LAS int* ptab;
#ifdef PROBE_EPI
    int skip;
#endif
    __device__ __forceinline__ void operator()(const pg8::f32x4 (&acc)[2][2][4][2], const pg8::Unit& u, int wr, int wc, int fr, int fq) const {
#ifdef PROBE_EPI
        if (skip) { if (acc[0][0][0][0][0] == 1.2345e-30f) Gm[0] = 0; return; }
#endif
        const int row0 = u.pm * 256 + wr * 64 + fr;
        const int e = __builtin_amdgcn_readfirstlane(ptab[u.pm]);
        const float* be = b1 + (size_t)e * 2048;
        const int j0 = u.pn * 128 + wc * 32 + 8 * fq;
        const f32x4 bg0 = *(const f32x4*)(be + j0), bg1 = *(const f32x4*)(be + j0 + 4), bu0 = *(const f32x4*)(be + 1024 + j0), bu1 = *(const f32x4*)(be + 1024 + j0 + 4);
        constexpr float DQ = 1.0f / (SC_X8 * SC_W8);
#pragma unroll
        for (int ai = 0; ai < 2; ++ai)
#pragma unroll
            for (int m = 0; m < 4; ++m) {
                const int row = row0 + ai * 128 + m * 16;
                float o[8];
#pragma unroll
                for (int n = 0; n < 2; ++n)
#pragma unroll
                    for (int k = 0; k < 4; ++k) {
                        const float hg = acc[ai][0][m][n][k] * DQ + (n ? bg1[k] : bg0[k]), hu = acc[ai][1][m][n][k] * DQ + (n ? bu1[k] : bu0[k]);
                        const float gi = fminf(hg, 7.0f), up = fminf(fmaxf(hu, -7.0f), 7.0f);
                        o[n * 4 + k] = (up + 1.0f) * gi * sigmoidf_(1.702f * gi) * SC_G8;
                    }
                v2u w; w.x = pk4_fp8(o[0], o[1], o[2], o[3]); w.y = pk4_fp8(o[4], o[5], o[6], o[7]);
                *(v2u*)(Gm + (size_t)row * FF + j0) = w;
            }
    }
};
struct EpiBias {
    static constexpr bool PERM = true, AFTER_DRAIN = false, BJADJ = true;
    bf16* Y; const float* b2; const LAS int* ptab;
#ifdef PROBE_EPI
    int skip; bf16* Y2;
#endif
    __device__ __forceinline__ void operator()(const pg8::f32x4 (&acc)[2][2][4][2], const pg8::Unit& u, int wr, int wc, int fr, int fq) const {
#ifdef PROBE_EPI
        if (skip && PROBE_EPI == 1) { if (acc[0][0][0][0][0] == 1.2345e-30f) Y[0] = 0; return; }
        if (skip) {
            const int row0 = u.pm * 256 + wr * 64 + fr; unsigned xo = 0u;
            _Pragma("unroll") for (int bj = 0; bj < 2; ++bj) { const int col0 = u.pn * 256 + wc * 64 + bj * 32 + 8 * fq;
                _Pragma("unroll") for (int ai = 0; ai < 2; ++ai) _Pragma("unroll") for (int m = 0; m < 4; ++m) { const int row = (row0 + ai * 128 + m * 16) & (PROBE_EPI == 4 ? 0xff : 0xffff);
                    const pg8::f32x4 v0 = acc[ai][bj][m][0] * (1.0f / (SC_G8 * SC_W8)) + 0.5f, v1 = acc[ai][bj][m][1] * (1.0f / (SC_G8 * SC_W8)) + 0.25f;
                    pg8::u32x4 w; w.x = pk2(v0[0], v0[1]); w.y = pk2(v0[2], v0[3]); w.z = pk2(v1[0], v1[1]); w.w = pk2(v1[2], v1[3]);
                    if (PROBE_EPI == 3) { xo ^= w.x ^ w.y ^ w.z ^ w.w; } else
                    *(pg8::u32x4*)(Y2 + (size_t)row * D + col0) = w; } }
            if (PROBE_EPI == 3 && xo == 0x12345678u) Y2[0] = 1;
            return; }
#endif
        const int row0 = u.pm * 256 + wr * 64 + fr;
        const int e = __builtin_amdgcn_readfirstlane(ptab[u.pm]);
        const float* be = b2 + (size_t)e * D;
        f32x4 bav[2], bbv[2];
#pragma unroll
        for (int bj = 0; bj < 2; ++bj) { const int col0 = u.pn * 256 + wc * 64 + bj * 32 + 8 * fq; bav[bj] = *(const f32x4*)(be + col0); bbv[bj] = *(const f32x4*)(be + col0 + 4); }
#pragma unroll
        for (int bj = 0; bj < 2; ++bj) {
            const int col0 = u.pn * 256 + wc * 64 + bj * 32 + 8 * fq;
            const f32x4 ba = bav[bj], bb = bbv[bj];
#pragma unroll
            for (int ai = 0; ai < 2; ++ai)
#pragma unroll
                for (int m = 0; m < 4; ++m) {
                    const int row = row0 + ai * 128 + m * 16;
                    const pg8::f32x4 v0 = acc[ai][bj][m][0] * (1.0f / (SC_G8 * SC_W8)) + ba, v1 = acc[ai][bj][m][1] * (1.0f / (SC_G8 * SC_W8)) + bb;
                    pg8::u32x4 w; w.x = pk2(v0[0], v0[1]); w.y = pk2(v0[2], v0[3]); w.z = pk2(v1[0], v1[1]); w.w = pk2(v1[2], v1[3]);
#ifdef PROBE_NT
                    { const bf16* ap_ = Y + (size_t)row * D + col0; asm volatile("global_store_dwordx4 %0, %1, off " PROBE_NT "\n\ts_nop 1" :: "v"(ap_), "v"(w) : "memory"); }
#else
                    *(pg8::u32x4*)(Y + (size_t)row * D + col0) = w;
#endif
                }
        }
    }
};

template <int MAP> __device__ __forceinline__ int colmap(int c) {
    if (MAP == 1) {
        const bool rope = (c < 512) || (c >= 768 && c < 1280) || (c >= 2304 && c < 2816) || (c >= 3072 && c < 3648);
        if (rope) { const int d = c & 63; return (c & ~63) + 2 * (d & 31) + (d >> 5); }
        return c;
    }
    if (MAP == 2) { const int sgl = c >> 10, j = c & 1023; return (j >> 7) * 256 + sgl * 128 + (j & 127); }
    if (MAP == 3) return c;
    return c;
}
template <int MAP> __device__ __forceinline__ void transpose_item(const float* W, int K, int N, bf16* WT, LAS float* scr, int item, int lane) {
    const int nblk = (N + 31) / 32, kb = item / nblk, nb = item % nblk, k0 = 128 * kb, n0 = 32 * nb;
    const int col = n0 + (lane & 31);
    float v[64];
    const float* src = W + (size_t)(k0 + (lane >> 5)) * N + col;
#pragma unroll
    for (int i = 0; i < 64; ++i) v[i] = (col < N) ? src[(size_t)(2 * i) * N] : 0.f;
#pragma unroll
    for (int i = 0; i < 64; ++i) scr[(2 * i + (lane >> 5)) * 33 + (lane & 31)] = v[i];
    LDS_WAIT(); asm volatile("" ::: "memory");
    const int c = lane & 7;
#pragma unroll
    for (int j = 0; j < 4; ++j) { const int n = (lane >> 3) + 8 * j; const LAS float* s = scr + (16 * c) * 33 + n;
        if (MAP >= 2) {
            v4u o8; o8.x = pk4_fp8(s[0 * 33] * SC_W8, s[1 * 33] * SC_W8, s[2 * 33] * SC_W8, s[3 * 33] * SC_W8); o8.y = pk4_fp8(s[4 * 33] * SC_W8, s[5 * 33] * SC_W8, s[6 * 33] * SC_W8, s[7 * 33] * SC_W8);
            o8.z = pk4_fp8(s[8 * 33] * SC_W8, s[9 * 33] * SC_W8, s[10 * 33] * SC_W8, s[11 * 33] * SC_W8); o8.w = pk4_fp8(s[12 * 33] * SC_W8, s[13 * 33] * SC_W8, s[14 * 33] * SC_W8, s[15 * 33] * SC_W8);
            if (n0 + n < N) *(GAS v4u*)((GAS unsigned char*)WT + (size_t)colmap<MAP>(n0 + n) * K + k0 + 16 * c) = o8;
        } else {
        v4u o, p; o.x = pk2(s[0 * 33], s[1 * 33]); o.y = pk2(s[2 * 33], s[3 * 33]); o.z = pk2(s[4 * 33], s[5 * 33]); o.w = pk2(s[6 * 33], s[7 * 33]);
        p.x = pk2(s[8 * 33], s[9 * 33]); p.y = pk2(s[10 * 33], s[11 * 33]); p.z = pk2(s[12 * 33], s[13 * 33]); p.w = pk2(s[14 * 33], s[15 * 33]);
        if (n0 + n < N) { GAS v4u* dst = (GAS v4u*)(WT + (size_t)colmap<MAP>(n0 + n) * K + k0 + 16 * c); dst[0] = o; dst[1] = p; } } }
    LDS_WAIT(); asm volatile("" ::: "memory");
}
__device__ __forceinline__ void p0_prologue(Frame& F) {
    PH_IDS; const float* w_in = LIN(1, 0); const float* w_out = LIN(11, 0); const float* exp_w1 = LIN(16, 0); const float* exp_w2 = LIN(18, 0);
    LAS float* scr = (LAS float*)(F.lds + w * 16896);
    const int gw = bid_ * NWAVES + w, NGW = G_ * NWAVES;
    constexpr int I_IN = 8 * ((INW + 31) / 32), I_OUT = 8 * 32, I_1 = 8 * 64, I_2 = 8 * 32;
    constexpr int N_IN = DEPTH * I_IN, N_OUT = DEPTH * I_OUT, N_1 = DEPTH * NE * I_1, N_2 = DEPTH * NE * I_2;
    constexpr int NITEMS = N_IN + N_OUT + N_1 + N_2;
    for (int it = gw; it < NITEMS; it += NGW) {
        int r = it;
        if (r < N_IN) { const int l = r / I_IN; transpose_item<1>(w_in + (size_t)l * D * INW, D, INW, WSP(bf16, WS_WIN) + (size_t)l * NP * D, scr, r % I_IN, lane); continue; } r -= N_IN;
#if P6_F8
        if (r < N_OUT) { const int l = r / I_OUT; transpose_item<3>(w_out + (size_t)l * D * D, D, D, (bf16*)(WSP(unsigned char, WS_WOUT) + (size_t)l * D * D), scr, r % I_OUT, lane); continue; } r -= N_OUT;
#else
        if (r < N_OUT) { const int l = r / I_OUT; transpose_item<0>(w_out + (size_t)l * D * D, D, D, WSP(bf16, WS_WOUT) + (size_t)l * D * D, scr, r % I_OUT, lane); continue; } r -= N_OUT;
#endif
        if (r < N_1) { const int m = r / I_1; transpose_item<2>(exp_w1 + (size_t)m * D * 2048, D, 2048, (bf16*)(WSP(unsigned char, WS_W1) + (size_t)m * 2048 * D), scr, r % I_1, lane); continue; } r -= N_1;
        { const int m = r / I_2; transpose_item<3>(exp_w2 + (size_t)m * FF * D, FF, D, (bf16*)(WSP(unsigned char, WS_W2) + (size_t)m * D * FF), scr, r % I_2, lane); }
    }
    const int gt = bid_ * NTHR + tid, NGT = G_ * NTHR;
    for (int i = gt; i < DEPTH * (NP - INW) * (D / 8); i += NGT) { const int l = i / ((NP - INW) * (D / 8)), rr = i % ((NP - INW) * (D / 8));
        *(GAS v4u*)(WSP(bf16, WS_WIN) + (size_t)l * NP * D + (size_t)INW * D + (size_t)rr * 8) = (v4u){0u, 0u, 0u, 0u}; }
    for (int i = gt; i < T * 32; i += NGT) { const int t = i >> 5, k = i & 31;
        const float inv = powf(10000.0f, -(float)(2 * k) / 64.0f); const float ang = (float)t * inv;
        f32x2 v; v.x = cosf(ang); v.y = sinf(ang); WSP(f32x2, WS_ROPE)[i] = v; }
    { const float* rw = LIN(14, 0);
      for (int i = gt; i < DEPTH * NE * D; i += NGT) { const int l = i / (NE * D), e = (i / D) % NE, k = i % D;
          const float wv = rw[(size_t)l * D * NE + (size_t)k * NE + e]; const unsigned hb = pk2(wv, 0.f) & 0xffffu; const float hf = __uint_as_float(hb << 16);
          bf16* dst = WSP(bf16, WS_RWB) + (size_t)l * 2 * NE * D + (size_t)e * D + k; dst[0] = (bf16)hb; dst[(size_t)NE * D] = (bf16)(pk2(wv - hf, 0.f) & 0xffffu); } }
    for (int i = gt; i < DEPTH * 2 * 4 * 64 * 64; i += NGT) { const int cc = i & 63, d = (i >> 6) & 63, n = (i >> 12) & 3, gate = (i >> 14) & 1, l = i >> 15;
        const float wv = LIN(gate ? 8 : 6, 0)[(size_t)l * 16384 + n * 4096 + cc * 64 + d]; WSP(bf16, WS_RGW)[i] = (bf16)(pk2(wv, 0.f) & 0xffffu); }
    { const f32x4* xs = (const f32x4*)LIN(0, 0); constexpr size_t NCH = (size_t)M * D / 8;
      for (size_t i0 = gt; i0 < NCH; i0 += (size_t)4 * NGT) {
          f32x4 a[4], b[4];
#pragma unroll
          for (int u = 0; u < 4; ++u) { const size_t i = i0 + (size_t)u * NGT; if (i < NCH) { a[u] = __builtin_nontemporal_load(xs + 2 * i); b[u] = __builtin_nontemporal_load(xs + 2 * i + 1); } }
#pragma unroll
          for (int u = 0; u < 4; ++u) { const size_t i = i0 + (size_t)u * NGT; if (i < NCH) { v4u o; o.x = pk2(a[u][0], a[u][1]); o.y = pk2(a[u][2], a[u][3]); o.z = pk2(b[u][0], b[u][1]); o.w = pk2(b[u][2], b[u][3]); WSP(v4u, WS_XB)[i] = o; } } } }
}

#ifndef PROBE_DSA
#define PROBE_DSA 0
#endif
__device__ __forceinline__ unsigned short score_key16(float s) {
    const _Float16 hf = (_Float16)s; const unsigned short h = __builtin_bit_cast(unsigned short, hf);
    return (h & 0x8000u) ? (unsigned short)~h : (unsigned short)(h | 0x8000u);
}
__device__ __forceinline__ void dsa_unit(Frame& F, int b, int qb) {
    PH_IDS; const int g = lane >> 4, li = lane & 15;
    LAS unsigned short* SCK = (LAS unsigned short*)F.lds;
    LAS unsigned* hist = (LAS unsigned*)(F.lctl + LC_HIST + w * 1024);
    const bf16* PJ = WSP(const bf16, WS_PJ);
    const int t0 = qb * 16;
    GAS unsigned long long* MK = (GAS unsigned long long*)WSP(unsigned long long, WS_MASK) + (size_t)(b * T + t0) * 64;
    if (t0 + 15 < 256) {
        for (int idx = tid; idx < 1024; idx += NTHR) { const int r = idx >> 6, l = idx & 63, n = t0 + r + 1 - l * 64;
            MK[idx] = n >= 64 ? ~0ull : (n <= 0 ? 0ull : ((1ull << n) - 1ull)); }
        return;
    }
    __syncthreads();
    {
        const int hh = lane >> 5, l31 = lane & 31;
        const int rq = 2 * (l31 >> 4) + ((l31 >> 2) & 1), rh = 4 * ((l31 >> 3) & 1) + (l31 & 3);
        bf16x8 af[4][4]; float wq[4][16];
#pragma unroll
        for (int rt = 0; rt < 4; ++rt) {
            const bf16* ap = PJ + (size_t)(b * T + t0 + 4 * rt + rq) * NP + C_QI + rh * 64 + 8 * hh;
#pragma unroll
            for (int ks = 0; ks < 4; ++ks) af[rt][ks] = *(const GAS bf16x8*)(ap + ks * 16);
#pragma unroll
            for (int qh = 0; qh < 2; ++qh) {
                const v4u wv = *(const GAS v4u*)(PJ + (size_t)(b * T + t0 + 4 * rt + 2 * qh + hh) * NP + C_W);
                wq[rt][8 * qh + 0] = bflo(wv.x); wq[rt][8 * qh + 1] = bfhi(wv.x); wq[rt][8 * qh + 2] = bflo(wv.y); wq[rt][8 * qh + 3] = bfhi(wv.y);
                wq[rt][8 * qh + 4] = bflo(wv.z); wq[rt][8 * qh + 5] = bfhi(wv.z); wq[rt][8 * qh + 6] = bflo(wv.w); wq[rt][8 * qh + 7] = bfhi(wv.w);
            }
        }
        const int nsub = (t0 + 15) / 32 + 1;
        const bf16* kp = PJ + (size_t)(b * T + l31) * NP + C_KI + 8 * hh;
#define DSA_LOAD(buf, jj) do { const int j_ = (jj) < nsub ? (jj) : 0; _Pragma("unroll") for (int ks = 0; ks < 4; ++ks) buf[ks] = *(const GAS bf16x8*)(kp + (size_t)j_ * 32 * NP + ks * 16); } while (0)
#define DSA_TILE(buf, jj) do { if ((jj) < nsub) { _Pragma("unroll") for (int rt = 0; rt < 4; ++rt) { \
            f32x16 acc; _Pragma("unroll") for (int i = 0; i < 16; ++i) acc[i] = 0.f; \
            _Pragma("unroll") for (int ks = 0; ks < 4; ++ks) acc = __builtin_amdgcn_mfma_f32_32x32x16_bf16(af[rt][ks], buf[ks], acc, 0, 0, 0); \
            float s0 = 0.f, s1 = 0.f; \
            _Pragma("unroll") for (int i = 0; i < 8; ++i) {   \
                const float r0 = __int_as_float(max(__float_as_int(acc[i]), 0)), r1 = __int_as_float(max(__float_as_int(acc[8 + i]), 0)); \
                s0 = fmaf(wq[rt][i], r0, s0); s1 = fmaf(wq[rt][8 + i], r1, s1); } \
            SCK[(4 * rt + hh) * 4096 + (jj) * 32 + l31] = score_key16(s0 + 0.0f); \
            SCK[(4 * rt + 2 + hh) * 4096 + (jj) * 32 + l31] = score_key16(s1 + 0.0f); } } } while (0)
        bf16x8 bX[4], bY[4], bZ[4];
        for (int prep_ = 0; prep_ < (((PROBE_DSA) & 1) ? 2 : 1); ++prep_) {
        DSA_LOAD(bX, w); DSA_LOAD(bY, w + 8);
        for (int j = w; j < nsub; j += 24) {
            DSA_LOAD(bZ, j + 16); DSA_TILE(bX, j);
            DSA_LOAD(bX, j + 24); DSA_TILE(bY, j + 8);
            DSA_LOAD(bY, j + 32); DSA_TILE(bZ, j + 16);
        }
        }
#undef DSA_LOAD
#undef DSA_TILE
    }
    __syncthreads();
#pragma unroll 1
    for (int rr_ = 0; rr_ < ((((PROBE_DSA) >> 1) & 1) ? 4 : 2); ++rr_) {
        const int rr = rr_ & 1;
        const int r = 2 * w + rr, t = t0 + r, ns = (t >> 6) + 1;
        unsigned key[64];
        const LAS unsigned short* kr = SCK + r * 4096 + lane;
#pragma unroll
        for (int g8 = 0; g8 < 8; ++g8) {
            if (g8 * 8 < ns) {
#pragma unroll
                for (int j = 0; j < 8; ++j) { const int i = g8 * 8 + j; const unsigned k = kr[64 * i]; key[i] = (64 * i + lane <= t) ? k : 0u; }
            } else {
#pragma unroll
                for (int j = 0; j < 8; ++j) key[g8 * 8 + j] = 0u;
            }
        }
        unsigned prefix = 0u; int kneed = 256;
#pragma unroll
        for (int pass = 0; pass < 2; ++pass) {
            const int shift = 8 - 8 * pass;
            *(LAS v4u*)(hist + 4 * lane) = (v4u){0u, 0u, 0u, 0u};
#pragma unroll
            for (int g8 = 0; g8 < 8; ++g8) {
                if (g8 * 8 < ns) {
#pragma unroll
                    for (int j = 0; j < 8; ++j) { const unsigned k = key[g8 * 8 + j];
                        const bool m = (k != 0u) && (pass == 0 || (k >> 8) == (prefix >> 8));
                        if (m) atomicAdd((unsigned*)(hist + ((k >> shift) & 255u)), 1u); }
                }
            }
            const v4u c = *(const LAS v4u*)(hist + 4 * lane);
            const int s4 = (int)(c.x + c.y + c.z + c.w);
            const int pre = wave_prefix_incl(s4);
            const int tot = __builtin_amdgcn_readlane(pre, 63);
            int run = tot - pre, fb = -1, fa = 0;
            if (run < kneed && kneed <= run + (int)c.w) { fb = 4 * lane + 3; fa = run; } run += (int)c.w;
            if (fb < 0 && run < kneed && kneed <= run + (int)c.z) { fb = 4 * lane + 2; fa = run; } run += (int)c.z;
            if (fb < 0 && run < kneed && kneed <= run + (int)c.y) { fb = 4 * lane + 1; fa = run; } run += (int)c.y;
            if (fb < 0 && run < kneed && kneed <= run + (int)c.x) { fb = 4 * lane + 0; fa = run; }
            const unsigned long long bm = __builtin_amdgcn_ballot_w64(fb >= 0);
            const int src = bm ? (int)__builtin_ctzll(bm) : 0;
            const int bsel = __builtin_amdgcn_readlane(fb, src), asel = __builtin_amdgcn_readlane(fa, src);
            prefix |= ((unsigned)bsel & 255u) << shift; kneed -= asel;
        }
        const unsigned thr = prefix;
        int remaining = kneed;
        unsigned long long word = 0ull;
#pragma unroll
        for (int g8 = 0; g8 < 8; ++g8) {
            if (g8 * 8 < ns) {
#pragma unroll
                for (int j = 0; j < 8; ++j) { const int i = g8 * 8 + j;
                    const unsigned long long gm = __builtin_amdgcn_ballot_w64(key[i] > thr); unsigned long long em = __builtin_amdgcn_ballot_w64(key[i] == thr);
                    int ne = __popcll(em);
                    if (ne > remaining) { while (__popcll(em) > remaining) em &= ~(1ull << (63 - __clzll((long long)em))); ne = remaining; }
                    remaining -= ne;
                    const unsigned long long wi = gm | em;
                    word = (lane == i) ? wi : word; }
            }
        }
        MK[r * 64 + lane] = word;
    }
}
__device__ __forceinline__ void ret_state_unit(Frame& F, int b, int h, int c) {
    PH_IDS;
    constexpr int TP = 136;
    LAS bf16* KT = (LAS bf16*)F.lds;
    LAS bf16* VT = KT + 64 * TP;
    const bf16* PJ = WSP(const bf16, WS_PJ);
    const float lg = log2f(1.0f - exp2f(-5.0f - (float)h));
    __syncthreads();
    {
        v4u kv[2], vv[2];
#pragma unroll
        for (int i = 0; i < 2; ++i) { const int idx = tid + NTHR * i, r = idx >> 3, cc = idx & 7;
            const size_t rb = (size_t)(b * T + c * 128 + r) * NP + h * 64 + cc * 8;
            kv[i] = *(const GAS v4u*)(PJ + rb + C_RK); vv[i] = *(const GAS v4u*)(PJ + rb + C_RV); }
#pragma unroll
        for (int i = 0; i < 2; ++i) { const int idx = tid + NTHR * i, r = idx >> 3, cc = idx & 7;
            const float z = exp2f((float)(127 - r) * lg);
            const unsigned k01 = pk2(bflo(kv[i].x) * z, bfhi(kv[i].x) * z), k23 = pk2(bflo(kv[i].y) * z, bfhi(kv[i].y) * z), k45 = pk2(bflo(kv[i].z) * z, bfhi(kv[i].z) * z), k67 = pk2(bflo(kv[i].w) * z, bfhi(kv[i].w) * z);
            LAS bf16* kd = KT + (cc * 8) * TP + r; LAS bf16* vd = VT + (cc * 8) * TP + r;
            kd[0 * TP] = (bf16)(k01 & 0xffffu); kd[1 * TP] = (bf16)(k01 >> 16); kd[2 * TP] = (bf16)(k23 & 0xffffu); kd[3 * TP] = (bf16)(k23 >> 16);
            kd[4 * TP] = (bf16)(k45 & 0xffffu); kd[5 * TP] = (bf16)(k45 >> 16); kd[6 * TP] = (bf16)(k67 & 0xffffu); kd[7 * TP] = (bf16)(k67 >> 16);
            vd[0 * TP] = (bf16)(vv[i].x & 0xffffu); vd[1 * TP] = (bf16)(vv[i].x >> 16); vd[2 * TP] = (bf16)(vv[i].y & 0xffffu); vd[3 * TP] = (bf16)(vv[i].y >> 16);
            vd[4 * TP] = (bf16)(vv[i].z & 0xffffu); vd[5 * TP] = (bf16)(vv[i].z >> 16); vd[6 * TP] = (bf16)(vv[i].w & 0xffffu); vd[7 * TP] = (bf16)(vv[i].w >> 16); }
    }
    __syncthreads();
    const int et = w >> 1, dt0 = (w & 1) * 2, j = lane & 15, g = lane >> 4;
    f32x4 acc0 = {0.f, 0.f, 0.f, 0.f}, acc1 = {0.f, 0.f, 0.f, 0.f};
#pragma unroll
    for (int ks = 0; ks < 4; ++ks) {
        const bf16x8 af = *(const LAS bf16x8*)(VT + (et * 16 + j) * TP + ks * 32 + 8 * g);
        const bf16x8 b0 = *(const LAS bf16x8*)(KT + (dt0 * 16 + j) * TP + ks * 32 + 8 * g), b1 = *(const LAS bf16x8*)(KT + ((dt0 + 1) * 16 + j) * TP + ks * 32 + 8 * g);
        acc0 = mfma16(af, b0, acc0); acc1 = mfma16(af, b1, acc1);
    }
    float* dst = WSP(float, WS_ST) + ((size_t)((b * 4 + h) * 32 + c) * 64 + et * 16 + 4 * g) * 64 + dt0 * 16 + j;
#pragma unroll
    for (int r = 0; r < 4; ++r) { dst[(size_t)r * 64] = acc0[r]; dst[(size_t)r * 64 + 16] = acc1[r]; }
}
__device__ __forceinline__ void kmean_unit(Frame& F, int b, int n) {
    PH_IDS;
    LAS float* part = (LAS float*)F.lds;
    LAS float* nmax = part + 16 * 256;
    const bf16* PJ = WSP(const bf16, WS_PJ);
    const int ch = tid & 31, rgp = tid >> 5;
    __syncthreads();
#pragma unroll
    for (int kind = 0; kind < 2; ++kind) {
        v4u v[16];
#pragma unroll
        for (int i = 0; i < 16; ++i) v[i] = *(const GAS v4u*)(PJ + (size_t)(b * T + n * 256 + rgp + 16 * i) * NP + (kind == 0 ? C_AK : C_DK) + ch * 8);
        float a8[8], m2 = 0.f;
#pragma unroll
        for (int k = 0; k < 8; ++k) a8[k] = 0.f;
#pragma unroll
        for (int i = 0; i < 16; ++i) {
            const float x0 = bflo(v[i].x), x1 = bfhi(v[i].x), x2 = bflo(v[i].y), x3 = bfhi(v[i].y), x4 = bflo(v[i].z), x5 = bfhi(v[i].z), x6 = bflo(v[i].w), x7 = bfhi(v[i].w);
            a8[0] += x0; a8[1] += x1; a8[2] += x2; a8[3] += x3; a8[4] += x4; a8[5] += x5; a8[6] += x6; a8[7] += x7;
            float ss = (x0 * x0 + x1 * x1) + (x2 * x2 + x3 * x3) + (x4 * x4 + x5 * x5) + (x6 * x6 + x7 * x7);
            ss += __shfl_xor(ss, 1); ss += __shfl_xor(ss, 2); ss += __shfl_xor(ss, 4);
            m2 = fmaxf(m2, ss);
        }
        if (kind == 0) {
#pragma unroll
            for (int k = 0; k < 8; ++k) part[rgp * 256 + ch * 8 + k] = a8[k];
        }
        if ((ch & 7) == 0) nmax[(kind * 16 + rgp) * 4 + (ch >> 3)] = m2;
    }
    __syncthreads();
    if (tid < 256) { float sum = 0.f;
#pragma unroll
        for (int r = 0; r < 16; ++r) sum += part[r * 256 + tid];
        WSP(bf16, WS_KMB)[((size_t)(b * 4 + (tid >> 6)) * 16 + n) * 64 + (tid & 63)] = (bf16)(pk2(sum * (1.0f / 256.0f), 0.f) & 0xffffu); }
    if (tid < 8) { const int kind = tid >> 2, hd = tid & 3; float m2 = 0.f;
#pragma unroll
        for (int r = 0; r < 16; ++r) m2 = fmaxf(m2, nmax[(kind * 16 + r) * 4 + hd]);
        WSP(float, WS_KN2)[((size_t)(kind * NB + b) * 4 + hd) * 16 + n] = m2; }
}
__device__ __forceinline__ void rg_local_unit(Frame& F, int b, int k) {
    PH_IDS;
    LAS float* XC = (LAS float*)F.lds;
    LAS float* AS = XC + 64 * 256;
    const bf16* PJ = WSP(const bf16, WS_PJ);
    const int c = tid & 255, th = tid >> 8;
    const int t0 = k * 64;
    const int gn = w >> 1, gh = w & 1, gj = lane & 15, gg = lane >> 4;
    bf16x8 bw[2][4][2];
    { const bf16* wt = WSP(const bf16, WS_RGW) + (size_t)F.layer * 32768 + (size_t)gn * 4096 + gj * 64 + 8 * gg;
#pragma unroll
      for (int gate = 0; gate < 2; ++gate)
#pragma unroll
          for (int dt = 0; dt < 4; ++dt)
#pragma unroll
              for (int ks = 0; ks < 2; ++ks) bw[gate][dt][ks] = *(const GAS bf16x8*)(wt + gate * 16384 + dt * 1024 + ks * 32); }
    __syncthreads();
    {
        LAS bf16* RAW = (LAS bf16*)AS;
        v4u rv[5];
#pragma unroll
        for (int i = 0; i < 5; ++i) { const int idx = tid + NTHR * i, rr = idx >> 5, cc = idx & 31, t = t0 - 3 + rr;
            rv[i] = (idx < 67 * 32 && t >= 0) ? *(const GAS v4u*)(PJ + (size_t)(b * T + t) * NP + C_CX + cc * 8) : (v4u){0u, 0u, 0u, 0u}; }
#pragma unroll
        for (int i = 0; i < 5; ++i) { const int idx = tid + NTHR * i; if (idx < 67 * 32) *(LAS v4u*)(RAW + idx * 8) = rv[i]; }
        __syncthreads();
        const float* cw_ = LIN(4, 1024);
        const float w0 = cw_[0 * 256 + c], w1 = cw_[1 * 256 + c], w2 = cw_[2 * 256 + c], w3 = cw_[3 * 256 + c], cb = LIN(5, 256)[c];
#pragma unroll 8
        for (int i = 0; i < 32; ++i) { const int tl = th + 2 * i;
            XC[tl * 256 + c] = cb + w0 * bf2f(RAW[tl * 256 + c]) + w1 * bf2f(RAW[(tl + 1) * 256 + c]) + w2 * bf2f(RAW[(tl + 2) * 256 + c]) + w3 * bf2f(RAW[(tl + 3) * 256 + c]); }
    }
    __syncthreads();
    float bt[2][4][4];
    {
        f32x4 ax[2][4], aa[2][4];
#pragma unroll
        for (int tt2 = 0; tt2 < 2; ++tt2)
#pragma unroll
            for (int dt = 0; dt < 4; ++dt) { ax[tt2][dt] = (f32x4){0.f, 0.f, 0.f, 0.f}; aa[tt2][dt] = (f32x4){0.f, 0.f, 0.f, 0.f}; }
#pragma unroll
        for (int tt2 = 0; tt2 < 2; ++tt2)
#pragma unroll
            for (int ks = 0; ks < 2; ++ks) {
                const LAS float* xp = XC + ((gh * 2 + tt2) * 16 + gj) * 256 + gn * 64 + ks * 32 + 8 * gg;
                const f32x4 x0 = *(const LAS f32x4*)xp, x1 = *(const LAS f32x4*)(xp + 4);
                v4u pa; pa.x = pk2(x0[0], x0[1]); pa.y = pk2(x0[2], x0[3]); pa.z = pk2(x1[0], x1[1]); pa.w = pk2(x1[2], x1[3]);
                const bf16x8 af = __builtin_bit_cast(bf16x8, pa);
#pragma unroll
                for (int dt = 0; dt < 4; ++dt) { ax[tt2][dt] = mfma16(af, bw[0][dt][ks], ax[tt2][dt]); aa[tt2][dt] = mfma16(af, bw[1][dt][ks], aa[tt2][dt]); }
            }
#pragma unroll
        for (int dt = 0; dt < 4; ++dt) {
            const int cch = gn * 64 + dt * 16 + gj;
            const float bx = LIN(7, 256)[cch], ba = LIN(9, 256)[cch], lam = LIN(10, 256)[cch];
            const float sp = log1pf(expf(-lam));
#pragma unroll
            for (int tt2 = 0; tt2 < 2; ++tt2)
#pragma unroll
                for (int r = 0; r < 4; ++r) {
                    const int tl = (gh * 2 + tt2) * 16 + 4 * gg + r;
                    const float gx = sigmoidf_(ax[tt2][dt][r] + bx), ga = sigmoidf_(aa[tt2][dt][r] + ba);
                    const float la = -8.0f * ga * sp; const float a = expf(la);
                    bt[tt2][dt][r] = sqrtf(-expm1f(2.0f * la)) * (gx * XC[tl * 256 + cch]);
                    AS[tl * 256 + cch] = a;
                }
        }
    }
    __syncthreads();
#pragma unroll
    for (int dt = 0; dt < 4; ++dt)
#pragma unroll
        for (int tt2 = 0; tt2 < 2; ++tt2)
#pragma unroll
            for (int r = 0; r < 4; ++r) XC[((gh * 2 + tt2) * 16 + 4 * gg + r) * 256 + gn * 64 + dt * 16 + gj] = bt[tt2][dt][r];
    __syncthreads();
    if (tid < 256) {
        float h = 0.f, P = 1.f;
        float* hl = WSP(float, WS_HLOC) + (size_t)(b * T + t0) * 256 + c; float* pc = WSP(float, WS_PC) + (size_t)(b * T + t0) * 256 + c;
        for (int tl = 0; tl < 64; ++tl) { const float a = AS[tl * 256 + c], bb = XC[tl * 256 + c]; h = fmaf(a, h, bb); P *= a; hl[(size_t)tl * 256] = h; pc[(size_t)tl * 256] = P; }
        WSP(float, WS_RGS)[(size_t)(b * 64 + k) * 256 + c] = P;
        WSP(float, WS_RGS)[(size_t)131072 + (size_t)(b * 64 + k) * 256 + c] = h;
    }
}

__device__ __forceinline__ void ret_prefix(Frame& F) {
    PH_IDS; const int gt = bid_ * NTHR + tid, NGT = G_ * NTHR;
    for (int i = gt; i < 32 * 4096; i += NGT) {
        const int bh = i >> 12, idx = i & 4095, h = bh & 3;
        const float gc = exp2f(128.0f * log2f(1.0f - exp2f(-5.0f - (float)h)));
        const float* st = WSP(const float, WS_ST) + (size_t)bh * 32 * 4096 + idx; bf16* rt = WSP(bf16, WS_RT) + (size_t)bh * 32 * 4096 + idx;
        float R = 0.f;
        for (int c = 0; c < 32; ++c) { rt[(size_t)c * 4096] = (bf16)(pk2(R, 0.f) & 0xffffu); R = st[(size_t)c * 4096] + gc * R; }
    }
}
__device__ __forceinline__ void rg_carry(Frame& F) {
    PH_IDS; const int gt = bid_ * NTHR + tid, NGT = G_ * NTHR;
    float* S = WSP(float, WS_RGS);
    for (int i = gt; i < NB * 256; i += NGT) {
        const int b = i >> 8, c = i & 255;
        float h = 0.f;
        for (int k = 0; k < 64; ++k) { const size_t o = (size_t)(b * 64 + k) * 256 + c; S[262144 + o] = h; h = fmaf(S[o], h, S[131072 + o]); }
    }
}

__device__ __forceinline__ bf16x8 pack8(const f32x4& a, const f32x4& b) {
    v4u w; w.x = pk2(a[0], a[1]); w.y = pk2(a[2], a[3]); w.z = pk2(b[0], b[1]); w.w = pk2(b[2], b[3]);
    return __builtin_bit_cast(bf16x8, w);
}
template <int MODE>
__device__ __forceinline__ void attn_unit(Frame& F, int b, int h, int qt) {
    PH_IDS; const int g = lane >> 4, li = lane & 15;
    LAS bf16* LB = (LAS bf16*)F.lds;
    LAS unsigned* wgsel = (LAS unsigned*)(F.lds + 2 * 9216 * 2);
    LAS v2u* plut = (LAS v2u*)(F.lds + 2 * 9216 * 2 + 64);
    const bf16* PJ = WSP(const bf16, WS_PJ);
    constexpr int qoff = MODE == 0 ? C_DQ : (MODE == 1 ? C_AQ : C_RQ), koff = MODE == 0 ? C_DK : (MODE == 1 ? C_AK : C_RK), voff = MODE == 0 ? C_DV : (MODE == 1 ? C_AV : C_RV);
    constexpr int ocol = MODE == 0 ? 768 : (MODE == 1 ? 0 : 256);
    const int q0 = qt * 256 + w * 32, wqmax = q0 + 31;
    bf16x8 qf[2][2];
#pragma unroll
    for (int qq = 0; qq < 2; ++qq)
#pragma unroll
        for (int ks = 0; ks < 2; ++ks) qf[qq][ks] = *(const GAS bf16x8*)(PJ + (size_t)(b * T + q0 + qq * 16 + li) * NP + qoff + h * 64 + ks * 32 + g * 8);
    f32x4 O[2][4], OL[2]; unsigned sel[2]; f32x4 negb[2];
#pragma unroll
    for (int qq = 0; qq < 2; ++qq) { sel[qq] = 0u; OL[qq] = (f32x4){0.f, 0.f, 0.f, 0.f}; negb[qq] = (f32x4){0.f, 0.f, 0.f, 0.f};
#pragma unroll
        for (int dt = 0; dt < 4; ++dt) O[qq][dt] = (f32x4){0.f, 0.f, 0.f, 0.f}; }
    unsigned wsel = 0xffffffffu;
    const float lg = (MODE == 2) ? log2f(1.0f - exp2f(-5.0f - (float)h)) : 0.f;
    if (MODE != 2) {
        const float* kn = WSP(const float, WS_KN2) + ((size_t)((MODE == 0 ? NB : 0) + b) * 4 + h) * 16;
        float km2 = 0.f;
        for (int n = 0; n <= qt; ++n) km2 = fmaxf(km2, kn[n]);
#pragma unroll
        for (int qq = 0; qq < 2; ++qq) {
            float q2 = 0.f;
#pragma unroll
            for (int ks = 0; ks < 2; ++ks) { const v4u qw = __builtin_bit_cast(v4u, qf[qq][ks]);
                q2 += (bflo(qw.x) * bflo(qw.x) + bfhi(qw.x) * bfhi(qw.x)) + (bflo(qw.y) * bflo(qw.y) + bfhi(qw.y) * bfhi(qw.y)) + (bflo(qw.z) * bflo(qw.z) + bfhi(qw.z) * bfhi(qw.z)) + (bflo(qw.w) * bflo(qw.w) + bfhi(qw.w) * bfhi(qw.w)); }
            q2 += __shfl_xor(q2, 16); q2 += __shfl_xor(q2, 32);
            const float bq = fminf(sqrtf(q2 * km2) * 1.001f + 1e-3f, 60.0f);
            negb[qq] = (f32x4){-bq, -bq, -bq, -bq};
        }
    }
    __syncthreads();
    if (tid < 16) { v2u e; e.x = ((tid & 1) ? 0xffffu : 0u) | ((tid & 2) ? 0xffff0000u : 0u); e.y = ((tid & 4) ? 0xffffu : 0u) | ((tid & 8) ? 0xffff0000u : 0u); plut[tid] = e; }
    if (MODE == 1) {
        const int own = qt;
        if (tid == 0) *wgsel = 0u;
        const bf16* km = WSP(const bf16, WS_KMB) + ((size_t)(b * 4 + h) * 16 + li) * 64;
        const bf16x8 km0 = *(const GAS bf16x8*)(km + g * 8), km1 = *(const GAS bf16x8*)(km + 32 + g * 8);
#pragma unroll
        for (int qq = 0; qq < 2; ++qq) {
            f32x4 gt4 = {0.f, 0.f, 0.f, 0.f};
            gt4 = mfma16(km0, qf[qq][0], gt4); gt4 = mfma16(km1, qf[qq][1], gt4);
            unsigned sq = 0u;
#pragma unroll
            for (int round = 0; round < 3; ++round) {
                float bv = -INFINITY; int bn = 99;
#pragma unroll
                for (int r = 0; r < 4; ++r) { const int n = g * 4 + r; if (n < own && !((sq >> n) & 1u) && gt4[r] > bv) { bv = gt4[r]; bn = n; } }
#pragma unroll
                for (int o = 16; o <= 32; o <<= 1) { const float ov = __shfl_xor(bv, o); const int on = __shfl_xor(bn, o); if (ov > bv || (ov == bv && on < bn)) { bv = ov; bn = on; } }
                if (bn < 16) sq |= 1u << bn;
            }
            sel[qq] = sq | (1u << own);
        }
        __syncthreads();
        if (g == 0) atomicOr((unsigned*)wgsel, sel[0] | sel[1]);
        __syncthreads();
        wsel = *wgsel;
    }
    const int kt_lo = (MODE == 2) ? 4 * qt : 0, kt_hi = 4 * qt + 3;
    const int sr = tid >> 3, sc = tid & 7;
    int kt = kt_lo;
    if (MODE == 1) { while (kt <= kt_hi && !((wsel >> (kt >> 2)) & 1u)) kt = (kt | 3) + 1; }
    v4u kreg, vreg;
    { const size_t rb = (size_t)(b * T + kt * 64 + sr) * NP + h * 64 + sc * 8; kreg = *(const GAS v4u*)(PJ + rb + koff); vreg = *(const GAS v4u*)(PJ + rb + voff); }
    const GAS unsigned long long* mkp = (const GAS unsigned long long*)WSP(const unsigned long long, WS_MASK) + (size_t)(b * T + q0 + li) * 64;
    unsigned long long mnx0 = ~0ull, mnx1 = ~0ull;
    if (MODE == 0) { mnx0 = mkp[kt]; mnx1 = mkp[16 * 64 + kt]; }
    const v4u onesw = (li == 0) ? (v4u){0x3f803f80u, 0x3f803f80u, 0x3f803f80u, 0x3f803f80u} : (v4u){0u, 0u, 0u, 0u};
    const bf16x8 onesf = __builtin_bit_cast(bf16x8, onesw);
    const f32x4 ninf4 = {-INFINITY, -INFINITY, -INFINITY, -INFINITY};
    int cur = 0;
    while (kt <= kt_hi) {
        LAS bf16* Ks = LB + cur * 9216; LAS bf16* Vt = Ks + 4608;
        *(LAS v4u*)(Ks + sr * 72 + sc * 8) = kreg;
        { LAS bf16* vd = Vt + (sc * 8) * 72 + (sr ^ (sc << 3));
          vd[0 * 72] = (bf16)(vreg.x & 0xffffu); vd[1 * 72] = (bf16)(vreg.x >> 16); vd[2 * 72] = (bf16)(vreg.y & 0xffffu); vd[3 * 72] = (bf16)(vreg.y >> 16);
          vd[4 * 72] = (bf16)(vreg.z & 0xffffu); vd[5 * 72] = (bf16)(vreg.z >> 16); vd[6 * 72] = (bf16)(vreg.w & 0xffffu); vd[7 * 72] = (bf16)(vreg.w >> 16); }
        __syncthreads();
        int ktn = kt + 1;
        if (MODE == 1) { while (ktn <= kt_hi && !((wsel >> (ktn >> 2)) & 1u)) ktn = (ktn | 3) + 1; }
        if (ktn <= kt_hi) { const size_t rb = (size_t)(b * T + ktn * 64 + sr) * NP + h * 64 + sc * 8; kreg = *(const GAS v4u*)(PJ + rb + koff); vreg = *(const GAS v4u*)(PJ + rb + voff); }
        const unsigned long long mcu0 = mnx0, mcu1 = mnx1;
        if (MODE == 0 && ktn <= kt_hi) { mnx0 = mkp[ktn]; mnx1 = mkp[16 * 64 + ktn]; }
        const bool diag = (kt * 64 + 63 > q0);
        const bool masked = (MODE == 0) || (MODE == 2) || diag;
        unsigned long long mwq[2]; f32x4 cin[2];
#pragma unroll
        for (int qq = 0; qq < 2; ++qq) {
            const int tqq = q0 + qq * 16 + li, d = tqq - kt * 64;
            unsigned long long cm = d >= 63 ? ~0ull : (d < 0 ? 0ull : ((2ull << d) - 1ull));
            if (MODE == 0) cm &= (qq == 0 ? mcu0 : mcu1);
            mwq[qq] = cm;
            cin[qq] = negb[qq];
            if (MODE == 1) cin[qq] = ((sel[qq] >> (kt >> 2)) & 1u) ? negb[qq] : ninf4;
        }
#pragma unroll
        for (int sub = 0; sub < 2; ++sub) {
            if (kt * 64 + sub * 32 > wqmax) continue;
            bf16x8 k0[2], k1[2];
#pragma unroll
            for (int ks = 0; ks < 2; ++ks) { k0[ks] = *(const LAS bf16x8*)(Ks + (sub * 32 + li) * 72 + ks * 32 + g * 8); k1[ks] = *(const LAS bf16x8*)(Ks + (sub * 32 + 16 + li) * 72 + ks * 32 + g * 8); }
            bf16x8 pb[2];
#pragma unroll
            for (int qq = 0; qq < 2; ++qq) {
                f32x4 s0, s1;
                if (MODE == 2) { s0 = (f32x4){0.f, 0.f, 0.f, 0.f}; s1 = s0; } else { s0 = cin[qq]; s1 = cin[qq]; }
                s0 = mfma16(k0[0], qf[qq][0], s0); s1 = mfma16(k1[0], qf[qq][0], s1); s0 = mfma16(k0[1], qf[qq][1], s0); s1 = mfma16(k1[1], qf[qq][1], s1);
                const unsigned nib0 = (unsigned)(mwq[qq] >> (sub * 32 + g * 4)) & 15u, nib1 = (unsigned)(mwq[qq] >> (sub * 32 + 16 + g * 4)) & 15u;
                if (MODE == 2) {
                    f32x4 p0, p1;
                    const int tqq = q0 + qq * 16 + li, kk0 = kt * 64 + sub * 32 + g * 4, kk1 = kk0 + 16;
#pragma unroll
                    for (int r = 0; r < 4; ++r) {
                        p0[r] = ((nib0 >> r) & 1u) ? s0[r] * __builtin_amdgcn_exp2f((float)(tqq - kk0 - r) * lg) : 0.f;
                        p1[r] = ((nib1 >> r) & 1u) ? s1[r] * __builtin_amdgcn_exp2f((float)(tqq - kk1 - r) * lg) : 0.f;
                    }
                    pb[qq] = pack8(p0, p1);
                } else {
                    f32x4 p0, p1;
#pragma unroll
                    for (int r = 0; r < 4; ++r) { p0[r] = __builtin_amdgcn_exp2f(s0[r]); p1[r] = __builtin_amdgcn_exp2f(s1[r]); }
                    v4u pw = __builtin_bit_cast(v4u, pack8(p0, p1));
                    if (masked) { const v2u ma = plut[nib0], mb = plut[nib1]; pw.x &= ma.x; pw.y &= ma.y; pw.z &= mb.x; pw.w &= mb.y; }
                    pb[qq] = __builtin_bit_cast(bf16x8, pw);
                }
            }
#pragma unroll
            for (int dt = 0; dt < 4; ++dt) {
                const int dim = dt * 16 + li, swz = ((dim >> 3) & 7) << 3;
                const LAS bf16* vrow = Vt + dim * 72;
                const v2u va = *(const LAS v2u*)(vrow + ((sub * 32 + g * 4) ^ swz)), vb = *(const LAS v2u*)(vrow + ((sub * 32 + 16 + g * 4) ^ swz));
                v4u vw; vw.x = va.x; vw.y = va.y; vw.z = vb.x; vw.w = vb.y;
                const bf16x8 vf = __builtin_bit_cast(bf16x8, vw);
                O[0][dt] = mfma16(vf, pb[0], O[0][dt]); O[1][dt] = mfma16(vf, pb[1], O[1][dt]);
            }
            if (MODE != 2) { OL[0] = mfma16(onesf, pb[0], OL[0]); OL[1] = mfma16(onesf, pb[1], OL[1]); }
        }
        kt = ktn; cur ^= 1;
    }
    bf16* MX = WSP(bf16, WS_MIX);
#pragma unroll
    for (int qq = 0; qq < 2; ++qq) {
        const int tqq = q0 + qq * 16 + li; const size_t qrow = (size_t)(b * T + tqq);
        if (MODE != 2) {
            const float lt = __shfl(OL[qq][0], li);
            const float inv = __builtin_amdgcn_rcpf(lt);
#pragma unroll
            for (int dt = 0; dt < 4; ++dt) {
#if P6_F8
                const float i8 = inv * SC_M8; *(GAS unsigned*)((GAS unsigned char*)MX + qrow * D + ocol + h * 64 + dt * 16 + g * 4) = pk4_fp8(O[qq][dt][0] * i8, O[qq][dt][1] * i8, O[qq][dt][2] * i8, O[qq][dt][3] * i8);
#else
                v2u o; o.x = pk2(O[qq][dt][0] * inv, O[qq][dt][1] * inv); o.y = pk2(O[qq][dt][2] * inv, O[qq][dt][3] * inv);
                *(GAS v2u*)(MX + qrow * D + ocol + h * 64 + dt * 16 + g * 4) = o;
#endif
            }
        } else {
            const bf16* rt = WSP(const bf16, WS_RT) + (size_t)((b * 4 + h) * 32 + 2 * qt) * 4096;
            const float xi = exp2f((float)((tqq & 255) + 1) * lg);
#pragma unroll
            for (int dt = 0; dt < 4; ++dt) {
                f32x4 cr = {0.f, 0.f, 0.f, 0.f};
                cr = mfma16(*(const GAS bf16x8*)(rt + (dt * 16 + li) * 64 + g * 8), qf[qq][0], cr); cr = mfma16(*(const GAS bf16x8*)(rt + (dt * 16 + li) * 64 + 32 + g * 8), qf[qq][1], cr);
                O[qq][dt] = O[qq][dt] + cr * xi;
            }
            float s = 0.f;
#pragma unroll
            for (int dt = 0; dt < 4; ++dt) s += (O[qq][dt][0] + O[qq][dt][1]) + (O[qq][dt][2] + O[qq][dt][3]);
            s += __shfl_xor(s, 16); s += __shfl_xor(s, 32);
            const float mu = s * (1.0f / 64.0f);
            float q = 0.f;
#pragma unroll
            for (int dt = 0; dt < 4; ++dt) { const f32x4 dd = O[qq][dt] - mu; q += (dd[0] * dd[0] + dd[1] * dd[1]) + (dd[2] * dd[2] + dd[3] * dd[3]); }
            q += __shfl_xor(q, 16); q += __shfl_xor(q, 32);
            const float rstd = 1.0f / sqrtf(q * (1.0f / 64.0f) + LN_EPS);
#pragma unroll
            for (int dt = 0; dt < 4; ++dt) {
                const int e0 = h * 64 + dt * 16 + g * 4;
                const f32x4 gg = *(const f32x4*)(LIN(2, 256) + e0), gb = *(const f32x4*)(LIN(3, 256) + e0);
                const v2u rg = *(const GAS v2u*)(PJ + qrow * NP + C_RG + e0);
                const float r0 = bflo(rg.x), r1 = bfhi(rg.x), r2 = bflo(rg.y), r3 = bfhi(rg.y);
                const float y0 = ((O[qq][dt][0] - mu) * rstd * gg[0] + gb[0]) * (r0 * sigmoidf_(r0)), y1 = ((O[qq][dt][1] - mu) * rstd * gg[1] + gb[1]) * (r1 * sigmoidf_(r1));
                const float y2 = ((O[qq][dt][2] - mu) * rstd * gg[2] + gb[2]) * (r2 * sigmoidf_(r2)), y3 = ((O[qq][dt][3] - mu) * rstd * gg[3] + gb[3]) * (r3 * sigmoidf_(r3));
#if P6_F8
                *(GAS unsigned*)((GAS unsigned char*)MX + qrow * D + ocol + e0) = pk4_fp8(y0 * SC_M8, y1 * SC_M8, y2 * SC_M8, y3 * SC_M8);
#else
                v2u o; o.x = pk2(y0, y1); o.y = pk2(y2, y3);
                *(GAS v2u*)(MX + qrow * D + ocol + e0) = o;
#endif
            }
        }
    }
}
__device__ __forceinline__ void rg_final_unit(Frame& F, int b, int k) {
    PH_IDS;
    const bf16* PJ = WSP(const bf16, WS_PJ); bf16* MX = WSP(bf16, WS_MIX);
    const int c4 = (tid & 63) * 4, tr = tid >> 6;
    const f32x4 hin = *(const f32x4*)(WSP(const float, WS_RGS) + 262144 + (size_t)(b * 64 + k) * 256 + c4);
    for (int i = 0; i < 8; ++i) {
        const size_t row = (size_t)(b * T + k * 64 + tr + 8 * i);
        const f32x4 hl = *(const f32x4*)(WSP(const float, WS_HLOC) + row * 256 + c4), pc = *(const f32x4*)(WSP(const float, WS_PC) + row * 256 + c4);
        const v2u gv = *(const GAS v2u*)(PJ + row * NP + C_CG + c4);
        const float gx[4] = {bflo(gv.x), bfhi(gv.x), bflo(gv.y), bfhi(gv.y)};
        float o[4];
#pragma unroll
        for (int j = 0; j < 4; ++j) { const float hh = fmaf(pc[j], hin[j], hl[j]); const float x = gx[j];
            const float ge = 0.5f * x * (1.0f + tanhf(0.7978845608028654f * (x + 0.044715f * x * x * x))); o[j] = hh * ge; }
#if P6_F8
        *(GAS unsigned*)((GAS unsigned char*)MX + row * D + 512 + c4) = pk4_fp8(o[0] * SC_M8, o[1] * SC_M8, o[2] * SC_M8, o[3] * SC_M8);
#else
        v2u ov; ov.x = pk2(o[0], o[1]); ov.y = pk2(o[2], o[3]);
        *(GAS v2u*)(MX + row * D + 512 + c4) = ov;
#endif
    }
}

__device__ __forceinline__ int moe_tables(Frame& F) {
    PH_IDS; LAS int* off = (LAS int*)(F.lctl + LC_OFF); LAS int* ptab = (LAS int*)(F.lctl + LC_PTAB);
    __syncthreads();
    if (tid == 0) {
        int o = 0;
        LAS int* cn = (LAS int*)(F.lctl + LC_CNT);
        for (int e = 0; e < NE; ++e) { off[e] = o; const int c = (int)__hip_atomic_load(F.ctl + CW_CNT + (F.layer * NE + e) * 64, RLX_AGENT); cn[e] = c; o += (c + 255) & ~255; }
        off[NE] = o;
    }
    __syncthreads();
    for (int p = tid; p < MAXPANELS; p += NTHR) { int e = 0;
        for (int k = 1; k < NE; ++k) e += (p * 256 >= off[k]) ? 1 : 0;
        ptab[p] = e; }
    __syncthreads();
    return off[NE] >> 8;
}
__device__ __forceinline__ void router_phase(Frame& F, const bool dry = false) {
    PH_IDS; const int g_ph = lane >> 4, li_ph = lane & 15;
    LAS float* LG = (LAS float*)F.lds + w * 512;
    LAS int* wcnt = (LAS int*)(F.lctl + LC_WCNT); LAS int* wbase = wcnt + 32;
    LAS int* rec = (LAS int*)(F.lctl + LC_REC);
    const bf16* Y1 = WSP(const bf16, WS_Y1); bf16* X1B = dry ? WSP(bf16, WS_XP) : WSP(bf16, WS_X1B);
    int* TOKO = dry ? (int*)(wsl + WS_XP + 64 * MiB) : WSP(int, WS_TOK); const int cofs = dry ? 2 * NE * 64 : 0;
    int* RT2 = dry ? (int*)(wsl + WS_XP + 80 * MiB) : WSP(int, WS_ROWTOK);
    const float* gamp = LIN(12, 1024); const float* betp = LIN(13, 1024); const float* rbp = LIN(15, 32);
    const bf16* rwb = WSP(const bf16, WS_RWB) + (size_t)F.layer * 2 * NE * D;
    __syncthreads();
    for (int rg = bid_; rg < M / 128; rg += G_) {
        if (tid < 32) wcnt[tid] = 0;
        __syncthreads();
        const size_t r0 = (size_t)rg * 128 + w * 16;
        int li = li_ph, g = g_ph; asm volatile("" : "+v"(li), "+v"(g));
        v4u xr[32];
        { const bf16* xrow = Y1 + (r0 + li) * D + g * 8;
#pragma unroll
          for (int ks = 0; ks < 32; ++ks) xr[ks] = *(const GAS v4u*)(xrow + ks * 32); }
        float s = 0.f;
#pragma unroll
        for (int ks = 0; ks < 32; ++ks) s += ((bflo(xr[ks].x) + bfhi(xr[ks].x)) + (bflo(xr[ks].y) + bfhi(xr[ks].y))) + ((bflo(xr[ks].z) + bfhi(xr[ks].z)) + (bflo(xr[ks].w) + bfhi(xr[ks].w)));
        s += __shfl_xor(s, 16); s += __shfl_xor(s, 32);
        const float mean = s * (1.0f / D);
#define XR_LAUNDER() _Pragma("unroll") for (int ks = 0; ks < 32; ++ks) asm volatile("" : "+v"(xr[ks]))
        XR_LAUNDER();
        float s2 = 0.f;
#pragma unroll
        for (int ks = 0; ks < 32; ++ks) { const float d0 = bflo(xr[ks].x) - mean, d1 = bfhi(xr[ks].x) - mean, d2 = bflo(xr[ks].y) - mean, d3 = bfhi(xr[ks].y) - mean, d4 = bflo(xr[ks].z) - mean, d5 = bfhi(xr[ks].z) - mean, d6 = bflo(xr[ks].w) - mean, d7 = bfhi(xr[ks].w) - mean;
            s2 += ((d0 * d0 + d1 * d1) + (d2 * d2 + d3 * d3)) + ((d4 * d4 + d5 * d5) + (d6 * d6 + d7 * d7)); }
        s2 += __shfl_xor(s2, 16); s2 += __shfl_xor(s2, 32);
        const float rstd = 1.0f / sqrtf(s2 * (1.0f / D) + LN_EPS);
        XR_LAUNDER();
#undef XR_LAUNDER
        f32x4 acc0 = {0.f, 0.f, 0.f, 0.f}, acc1 = {0.f, 0.f, 0.f, 0.f};
        bf16* xbrow = X1B + (r0 + li) * D + g * 8; unsigned char* xqrow = (dry ? (unsigned char*)(wsl + WS_XP + 96 * MiB) : WSP(unsigned char, WS_X1Q)) + (r0 + li) * D + g * 8;
        const bf16* wrow = rwb + (size_t)li * D + g * 8;
#pragma unroll
        for (int ks = 0; ks < 32; ++ks) {
            const f32x4 xa = {bflo(xr[ks].x), bfhi(xr[ks].x), bflo(xr[ks].y), bfhi(xr[ks].y)}, xb4 = {bflo(xr[ks].z), bfhi(xr[ks].z), bflo(xr[ks].w), bfhi(xr[ks].w)};
            const f32x4 ga = *(const f32x4*)(gamp + ks * 32 + g * 8), gb4 = *(const f32x4*)(gamp + ks * 32 + g * 8 + 4);
            const f32x4 ba = *(const f32x4*)(betp + ks * 32 + g * 8), bb4 = *(const f32x4*)(betp + ks * 32 + g * 8 + 4);
            const bf16x8 wh0 = *(const GAS bf16x8*)(wrow + ks * 32), wh1 = *(const GAS bf16x8*)(wrow + (size_t)16 * D + ks * 32);
            const bf16x8 wl0 = *(const GAS bf16x8*)(wrow + (size_t)NE * D + ks * 32), wl1 = *(const GAS bf16x8*)(wrow + (size_t)NE * D + (size_t)16 * D + ks * 32);
            const f32x4 na = (xa - mean) * rstd * ga + ba, nb = (xb4 - mean) * rstd * gb4 + bb4;
            v4u hw; hw.x = pk2(na[0], na[1]); hw.y = pk2(na[2], na[3]); hw.z = pk2(nb[0], nb[1]); hw.w = pk2(nb[2], nb[3]);
            *(GAS v4u*)(xbrow + ks * 32) = hw;
            { v2u q; q.x = pk4_fp8(na[0] * SC_X8, na[1] * SC_X8, na[2] * SC_X8, na[3] * SC_X8); q.y = pk4_fp8(nb[0] * SC_X8, nb[1] * SC_X8, nb[2] * SC_X8, nb[3] * SC_X8); *(GAS v2u*)(xqrow + ks * 32) = q; }
            v4u lw; lw.x = pk2(na[0] - bflo(hw.x), na[1] - bfhi(hw.x)); lw.y = pk2(na[2] - bflo(hw.y), na[3] - bfhi(hw.y));
                    lw.z = pk2(nb[0] - bflo(hw.z), nb[1] - bfhi(hw.z)); lw.w = pk2(nb[2] - bflo(hw.w), nb[3] - bfhi(hw.w));
            const bf16x8 ah = __builtin_bit_cast(bf16x8, hw), al = __builtin_bit_cast(bf16x8, lw);
            acc0 = mfma16(ah, wh0, acc0); acc1 = mfma16(ah, wh1, acc1);
            acc0 = mfma16(ah, wl0, acc0); acc1 = mfma16(ah, wl1, acc1);
            acc0 = mfma16(al, wh0, acc0); acc1 = mfma16(al, wh1, acc1);
            if (ks & 1) __builtin_amdgcn_sched_barrier(0);
        }
        {
            const float b0 = rbp[li], b1 = rbp[16 + li];
#pragma unroll
            for (int r = 0; r < 4; ++r) { LG[(g * 4 + r) * 32 + li] = acc0[r] + b0; LG[(g * 4 + r) * 32 + 16 + li] = acc1[r] + b1; }
        }
        LDS_WAIT(); asm volatile("" ::: "memory");
        if (lane < 16) {
            float lg[32];
#pragma unroll
            for (int e4 = 0; e4 < 8; ++e4) { const f32x4 t = *(const LAS f32x4*)(LG + lane * 32 + e4 * 4); lg[e4 * 4] = t[0]; lg[e4 * 4 + 1] = t[1]; lg[e4 * 4 + 2] = t[2]; lg[e4 * 4 + 3] = t[3]; }
            int te[4]; float tv[4]; unsigned used = 0u;
#pragma unroll
            for (int k = 0; k < 4; ++k) { float bv = -INFINITY; int be = 0;
#pragma unroll
                for (int e = 0; e < 32; ++e) { const bool ok = !((used >> e) & 1u) && lg[e] > bv; bv = ok ? lg[e] : bv; be = ok ? e : be; }
                te[k] = be; tv[k] = bv; used |= 1u << be; }
            const float e1 = __expf(tv[1] - tv[0]), e2 = __expf(tv[2] - tv[0]), e3 = __expf(tv[3] - tv[0]);
            const float inv = 1.0f / (1.0f + e1 + e2 + e3);
            const float gk[4] = {inv, e1 * inv, e2 * inv, e3 * inv};
            const int rl = w * 16 + lane;
#pragma unroll
            for (int k = 0; k < 4; ++k) { const int lr = atomicAdd((int*)&wcnt[te[k]], 1); rec[(rl * 4 + k) * 3 + 0] = te[k]; rec[(rl * 4 + k) * 3 + 1] = lr; rec[(rl * 4 + k) * 3 + 2] = __float_as_int(gk[k]); }
        }
        __syncthreads();
        if (tid < 32) wbase[tid] = (int)__hip_atomic_fetch_add(F.ctl + CW_CNT + cofs + (F.layer * NE + tid) * 64, (unsigned)wcnt[tid], RLX_AGENT);
        __syncthreads();
        {
            const int rl = tid >> 2, k = tid & 3; const size_t o = ((size_t)rg * 128 + rl) * 4 + k;
            const int e = rec[(rl * 4 + k) * 3 + 0];
            const int rk = wbase[e] + rec[(rl * 4 + k) * 3 + 1];
            TOKO[o] = e; TOKO[131072 + o] = rk; TOKO[3 * 131072 + o] = rec[(rl * 4 + k) * 3 + 2];
            RT2[(size_t)e * RT2_CAP + rk] = (int)(o >> 2);
        }
        __syncthreads();
    }
}
__device__ __forceinline__ void combine_phase(Frame& F, bool last) {
    (void)moe_tables(F);
    const LAS int* off = (const LAS int*)(F.lctl + LC_OFF);
    PH_IDS; float* xout = last ? (float*)(__attribute__((address_space(1))) float*)Al->out : WSP(float, WS_XF); const int gw = bid_ * NWAVES + w, NGW = G_ * NWAVES;
    const bf16* X1Bc = WSP(const bf16, WS_X1B); const bf16* Y = WSP(const bf16, WS_PJ); const int* TOK = WSP(const int, WS_TOK); bf16* XB = WSP(bf16, WS_XB);
    f32x4 gam[4], bet[4];
#pragma unroll
    for (int j = 0; j < 4; ++j) { gam[j] = *(const f32x4*)(LIN(20, 1024) + 4 * (lane + 64 * j)); bet[j] = *(const f32x4*)(LIN(21, 1024) + 4 * (lane + 64 * j)); }
#define CB_LOAD(yv, xv, ii) do { const int row_ = gw + (i0 + (ii)) * NGW; if (row_ < M) { \
        _Pragma("unroll") for (int k = 0; k < 4; ++k) { const int slot_ = __builtin_amdgcn_readlane(slot_l, ((ii) & 15) * 4 + k); \
            _Pragma("unroll") for (int j = 0; j < 4; ++j) yv[k][j] = *(const GAS v2u*)(Y + (size_t)slot_ * D + 4 * (lane + 64 * j)); } \
        _Pragma("unroll") for (int j = 0; j < 4; ++j) xv[j] = *(const GAS v2u*)(X1Bc + (size_t)row_ * D + 4 * (lane + 64 * j)); } } while (0)
#define CB_COMP(yv, xv, ii) do { const int row_ = gw + (i0 + (ii)) * NGW; if (row_ < M) { f32x4 v[4]; \
        _Pragma("unroll") for (int j = 0; j < 4; ++j) v[j] = (f32x4){bflo(xv[j].x), bfhi(xv[j].x), bflo(xv[j].y), bfhi(xv[j].y)} * ALPHA_RES; \
        _Pragma("unroll") for (int k = 0; k < 4; ++k) { const float gk = __int_as_float(__builtin_amdgcn_readlane(gate_l, ((ii) & 15) * 4 + k)); \
            _Pragma("unroll") for (int j = 0; j < 4; ++j) { v[j][0] = fmaf(gk, bflo(yv[k][j].x), v[j][0]); v[j][1] = fmaf(gk, bfhi(yv[k][j].x), v[j][1]); v[j][2] = fmaf(gk, bflo(yv[k][j].y), v[j][2]); v[j][3] = fmaf(gk, bfhi(yv[k][j].y), v[j][3]); } } \
        float s_ = 0.f; _Pragma("unroll") for (int j = 0; j < 4; ++j) s_ += (v[j][0] + v[j][1]) + (v[j][2] + v[j][3]); \
        const float mean_ = wave_sum(s_) * (1.0f / D); float s2_ = 0.f; \
        _Pragma("unroll") for (int j = 0; j < 4; ++j) { v[j] = v[j] - mean_; s2_ += (v[j][0] * v[j][0] + v[j][1] * v[j][1]) + (v[j][2] * v[j][2] + v[j][3] * v[j][3]); } \
        const float rstd_ = 1.0f / sqrtf(wave_sum(s2_) * (1.0f / D) + LN_EPS); \
        _Pragma("unroll") for (int j = 0; j < 4; ++j) { v[j] = v[j] * rstd_ * gam[j] + bet[j]; \
            if (last) *(GAS f32x4*)(xout + (size_t)row_ * D + 4 * (lane + 64 * j)) = v[j]; \
            else { v2u o_; o_.x = pk2(v[j][0], v[j][1]); o_.y = pk2(v[j][2], v[j][3]); *(GAS v2u*)(XB + (size_t)row_ * D + 4 * (lane + 64 * j)) = o_; } } } } while (0)
    const int nper = (M + NGW - 1) / NGW;
    for (int i0 = 0; i0 < nper; i0 += 16) {
        int slot_l = 0, gate_l = 0;
        { const int rl = gw + (i0 + (lane >> 2)) * NGW;
          if (i0 + (lane >> 2) < nper && rl < M) { const size_t o = (size_t)rl * 4 + (lane & 3); slot_l = off[TOK[o]] + TOK[131072 + o]; gate_l = TOK[3 * 131072 + o]; } }
        v2u yA[4][4], xA[4], yB[4][4], xB[4];
        CB_LOAD(yA, xA, 0);
#pragma unroll 1
        for (int ii = 0; ii < 16; ii += 2) {
            CB_LOAD(yB, xB, ii + 1); CB_COMP(yA, xA, ii);
            if (ii + 2 < 16) CB_LOAD(yA, xA, ii + 2);
            CB_COMP(yB, xB, ii + 1);
        }
    }
#undef CB_LOAD
#undef CB_COMP
}

constexpr int NPHASE = 1 + 10 * DEPTH;
#if ONE_LAUNCH
#ifndef PROBE_BAR
#define PROBE_BAR 0
#endif
#define GRID_BAR() do { xcd_barrier(bar); if (PROBE_BAR) xcd_barrier(bar); } while (0)
#else
#define GRID_BAR() do { } while (0)
#endif
#ifndef STG_P1
#define STG_P1 0
#define STG_P6 0
#define STG_G1 8
#define STG_G2 20
#endif
#define KIND(k) ((k) == 0 ? 0 : (((k) - 1) % 10) + 1)
#define IN(k) (((PHM >> KIND(k)) & 1) && lo <= (k) && (k) < hi)
#define SEAM(k) do { if (IN(k) && IN((k) + 1)) GRID_BAR(); } while (0)
#ifndef PROBE_DBL
#define PROBE_DBL 0
#endif
#define REPS(kind) for (int rep_ = 0; rep_ < (((PROBE_DBL >> (kind)) & 1) ? 2 : 1); ++rep_)
#ifndef PROBE_X1SUB
#define PROBE_X1SUB 0
#endif
#define SUBREP(k) for (int r2_ = 0; r2_ < ((PROBE_X1SUB == (k)) ? 2 : 1); ++r2_)
#if !ONE_LAUNCH
struct XcdBarrierDummy { int x; };
#endif
template <int PHM, int l, class Bar>
__device__ __forceinline__ void layer_phases(Frame& F, Bar& bar, const int lo, const int hi) {
    (void)bar;
        const int pb = 1 + 10 * l;
        F.layer = l;
        if (IN(pb + 0)) {
            REPS(1) {
            PH_PTRS;
            pg8::StaticOrder S; S.init(WSP(const bf16, WS_XB), WSP(const bf16, WS_WIN) + (size_t)l * NP * D, M, NP, D, G_, bid_);
#ifdef PROBE_EPI
            EpiProj E{WSP(bf16, WS_PJ), WSP(const f32x2, WS_ROPE), rep_};
#else
            EpiProj E{WSP(bf16, WS_PJ), WSP(const f32x2, WS_ROPE)};
#endif
            pg8::gemm_phase<EpiProj, pg8::StaticOrder, true, true, false, STG_P1>(F.lds, D, S, E);
            }
            SEAM(pb + 0);
        }
        if (IN(pb + 1)) {
            REPS(2) {
            PH_PTRS;
            constexpr int N_DS = NB * 256, N_RS = NB * 4 * 32, N_RG = NB * 64, N_KM = NB * 16;
            REPS(12) {
                const int nround = (N_DS + G_ - 1) / G_;
                for (int k = 0; k < nround; ++k) {
                    const int u = k * G_ + ((k & 1) ? (G_ - 1 - bid_) : bid_);
                    if (u >= N_DS) continue;
                    dsa_unit(F, u & 7, 255 - (u >> 3));
                }
            }
            REPS(13) for (int u = bid_; u < N_RS + N_RG + N_KM; u += G_) {
                if (u < N_RS) { SUBREP(1) ret_state_unit(F, u >> 7, (u >> 5) & 3, u & 31); }
                else if (u < N_RS + N_RG) { const int v = u - N_RS; SUBREP(2) rg_local_unit(F, v >> 6, v & 63); }
                else { const int v = u - N_RS - N_RG; SUBREP(3) kmean_unit(F, v >> 4, v & 15); }
            }
            }
            SEAM(pb + 1);
        }
        if (IN(pb + 2)) {
            REPS(11) { ret_prefix(F); rg_carry(F); }
            SEAM(pb + 2);
        }
        if (IN(pb + 3)) {
            REPS(4) {
            PH_PTRS;
            const int nround = (1024 + G_ - 1) / G_;
            REPS(14) for (int k = 0; k < nround; ++k) {
                const int u = k * G_ + ((k & 1) ? (G_ - 1 - bid_) : bid_);
                if (u >= 1024) continue;
                const int qt = 15 - (u >> 6), rem = u & 63, b = (rem & 31) >> 2, h = rem & 3;
                if (rem >> 5) attn_unit<1>(F, b, h, qt); else attn_unit<0>(F, b, h, qt);
            }
            REPS(15) for (int u = bid_; u < 512; u += G_) attn_unit<2>(F, u >> 6, (u >> 4) & 3, u & 15);
            REPS(16) for (int u = bid_; u < 512; u += G_) rg_final_unit(F, u >> 6, u & 63);
            }
            SEAM(pb + 3);
        }
        if (IN(pb + 4)) {
            REPS(5) {
            PH_PTRS;
#if P6_F8
            pg8::StaticOrder S; S.init(WSP(const unsigned char, WS_MIX), WSP(const unsigned char, WS_WOUT) + (size_t)l * D * D, M, D, D / 2, G_, bid_);
#else
            pg8::StaticOrder S; S.init(WSP(const bf16, WS_MIX), WSP(const bf16, WS_WOUT) + (size_t)l * D * D, M, D, D, G_, bid_);
#endif
            typedef EpiRes ER;
#ifdef PROBE_EPI
            ER E{WSP(const bf16, WS_XB), WSP(bf16, WS_Y1), rep_};
#else
            ER E{WSP(const bf16, WS_XB), WSP(bf16, WS_Y1)};
#endif
            pg8::gemm_phase<ER, pg8::StaticOrder, true, true, (P6_F8 != 0), STG_P6>(F.lds, P6_F8 ? D / 2 : D, S, E);
            }
            SEAM(pb + 4);
        }
        if (IN(pb + 5)) { if ((PROBE_DBL >> 6) & 1) router_phase(F, true); router_phase(F); if (IN(pb + 7)) GRID_BAR(); }
        if (IN(pb + 7)) {
            REPS(8) {
            const int np = moe_tables(F);
            PH_PTRS;
            pg8::MoeGatherOrder S; S.init(8, np, G_, bid_); S.Ab = (const char*)WSP(const unsigned char, WS_X1Q); S.rowtok = WSP(const int, WS_ROWTOK); S.off = (const LAS int*)(F.lctl + LC_OFF); S.cnt = (const LAS int*)(F.lctl + LC_CNT); S.rowbytes = (unsigned)D; S.Wb = (const char*)(WSP(const unsigned char, WS_W1) + (size_t)l * NE * 2048 * D);
            S.tstep = (size_t)256 * D; S.estride = (size_t)2048 * D; S.ptab = (const LAS int*)(F.lctl + LC_PTAB);
#ifdef PROBE_EPI
            EpiSwiglu E{WSP(unsigned char, WS_G), LIN(17, 65536), (const LAS int*)(F.lctl + LC_PTAB), rep_};
#else
            EpiSwiglu E{WSP(unsigned char, WS_G), LIN(17, 65536), (const LAS int*)(F.lctl + LC_PTAB)};
#endif
            pg8::gemm_phase<EpiSwiglu, pg8::MoeGatherOrder, true, true, true, STG_G1>(F.lds, D / 2, S, E);
            }
            SEAM(pb + 7);
        }
        if (IN(pb + 8)) {
            REPS(9) {
            const int np = moe_tables(F);
            PH_PTRS;
            pg8::MoeOrder S; S.init(4, np, G_, bid_); S.Ab = (const char*)WSP(const unsigned char, WS_G); S.Wb = (const char*)(WSP(const unsigned char, WS_W2) + (size_t)l * NE * D * FF);
            S.tstep = (size_t)256 * FF; S.estride = (size_t)D * FF; S.ptab = (const LAS int*)(F.lctl + LC_PTAB);
#ifdef PROBE_EPI
            EpiBias E{WSP(bf16, WS_PJ), LIN(19, 32768), (const LAS int*)(F.lctl + LC_PTAB), rep_, (bf16*)(wsl + WS_XP + 48 * MiB)};
#else
            EpiBias E{WSP(bf16, WS_PJ), LIN(19, 32768), (const LAS int*)(F.lctl + LC_PTAB)};
#endif
            pg8::gemm_phase<EpiBias, pg8::MoeOrder, true, true, true, STG_G2>(F.lds, FF / 2, S, E);
            }
            SEAM(pb + 8);
        }
        if (IN(pb + 9)) { REPS(10) combine_phase(F, l == DEPTH - 1); SEAM(pb + 9); }
}

template <int PHM> __global__ void __launch_bounds__(NTHR, 2) fwd(Args args) {
    extern __shared__ __attribute__((aligned(16))) unsigned char lds[];
    Frame F;
    F.lds = (LAS unsigned char*)lds; F.lctl = F.lds + LDSCTL_OFF;
    F.G = gridDim.x; F.bid = blockIdx.x; F.ws = args.ws; F.ctl = (gu32*)(args.ws + WS_CTL); F.layer = 0;
    for (int u = threadIdx.x; u < (LDS_BYTES - LDSCTL_OFF) / 4; u += NTHR) ((LAS unsigned*)F.lctl)[u] = 0u;
    __syncthreads();
    const int lo = args.ph_lo, hi = args.ph_hi;
#if ONE_LAUNCH
    XcdBarrier bar = xcd_barrier_post((unsigned*)(F.ctl + CW_BAR), (volatile LAS unsigned*)(F.lctl + LC_MISC));
#else
    XcdBarrierDummy bar{0};
#endif
    if (IN(0)) { REPS(0) p0_prologue(F); SEAM(0); }

    layer_phases<PHM, 0>(F, bar, lo, hi);
    layer_phases<PHM, 1>(F, bar, lo, hi);
    static_assert(DEPTH == 2, "two layer_phases calls");
#undef IN
#undef SEAM
}

typedef void (*KernelFn)(Args);
template <int K> static KernelFn kind_fn() { return fwd<(1 << K)>; }
extern "C" void kernel_launch(void* const* d_in, const int* in_sizes, int n_in, void* d_out, int out_size, void* d_ws, size_t ws_size, hipStream_t stream) {
    static int grid = 0;
#if ONE_LAUNCH
    static KernelFn fns[1] = { fwd<0x7ff> };
    constexpr int NFN = 1;
#else
    static KernelFn fns[11] = { kind_fn<0>(), kind_fn<1>(), kind_fn<2>(), kind_fn<3>(), kind_fn<4>(), kind_fn<5>(), kind_fn<6>(), kind_fn<7>(), kind_fn<8>(), kind_fn<9>(), kind_fn<10>() };
    constexpr int NFN = 11;
#endif
    if (grid == 0) {
        if (n_in != 22 || in_sizes[0] != M * D || out_size != M * D || ws_size < WS_END) {
            fprintf(stderr, "kernel_launch: unexpected shapes (n_in %d, in0 %d, out %d, ws %zu, need %zu); nothing launched\n", n_in, n_in > 0 ? in_sizes[0] : -1, out_size, ws_size, (size_t)WS_END); grid = -1; return; }
        int dev = 0, cus = 0;
        if (hipGetDevice(&dev) != hipSuccess || hipDeviceGetAttribute(&cus, hipDeviceAttributeMultiprocessorCount, dev) != hipSuccess) { fprintf(stderr, "kernel_launch: device query failed\n"); grid = -1; return; }
        for (int i = 0; i < NFN; ++i)
            if (hipFuncSetAttribute((const void*)fns[i], hipFuncAttributeMaxDynamicSharedMemorySize, LDS_BYTES) != hipSuccess) { fprintf(stderr, "kernel_launch: hipFuncSetAttribute failed\n"); grid = -1; return; }
        (void)hipGetLastError();
        grid = cus;
    }
    if (grid < 0) return;
    if (hipMemsetAsync((char*)d_ws + WS_CTL, 0, CTL_ZERO_BYTES, stream) != hipSuccess) { fprintf(stderr, "kernel_launch: memset failed\n"); return; }
    Args a{};
    for (int i = 0; i < 22; ++i) a.in[i] = (const float*)d_in[i];
    a.out = (float*)d_out; a.ws = (unsigned char*)d_ws;
#if ONE_LAUNCH
    a.ph_lo = 0; a.ph_hi = NPHASE;
    hipLaunchKernelGGL(fns[0], dim3(grid), dim3(NTHR), LDS_BYTES, stream, a);
#else
    for (int p = 0; p < NPHASE; ++p) { a.ph_lo = p; a.ph_hi = p + 1; const int kind = (p == 0) ? 0 : ((p - 1) % 10) + 1;
        hipLaunchKernelGGL(fns[kind], dim3(grid), dim3(NTHR), LDS_BYTES, stream, a); }
#endif
}
```

```cpp
#include <hip/hip_runtime.h>
#include <cstdio>
#include <cstdint>

#ifndef ONE_LAUNCH
#define ONE_LAUNCH 1
#endif

namespace pg8 {
#define PG8_LAS __attribute__((address_space(3)))
typedef unsigned short bf16_t;
typedef short bf16x8 __attribute__((ext_vector_type(8)));
typedef float f32x4 __attribute__((ext_vector_type(4)));
typedef unsigned u32x4 __attribute__((ext_vector_type(4)));
constexpr int BM = 256, BK = 64, HALF = 128, HTB = HALF * BK * 2  , STAGE_BYTES = 8 * HTB, NXCD = 8, WGM = 8;

__host__ __device__ __forceinline__ int lds_byte(int r, int c) { const int st = (r >> 4) * 2 + (c >> 5), rr = r & 15, cc = c & 31, ob = rr * 64 + cc * 2; return st * 1024 + (ob ^ (((ob >> 9) & 1) << 5)); }
__host__ __device__ __forceinline__ void stage_rc(int b, int& R, int& C) { const int st = b / 1024, sb = b % 1024, swz = sb ^ (((sb >> 9) & 1) << 5); R = (st >> 1) * 16 + swz / 64; C = (st & 1) * 32 + (swz % 64) / 2; }
__host__ __device__ __forceinline__ int perm32(int rho) { const int n = rho >> 4, i = rho & 15; return 8 * (i >> 2) + 4 * n + (i & 3); }

struct Unit { int pm, pn; };

struct StaticOrder {
    static constexpr bool GATHER = false;
    __device__ __forceinline__ unsigned rowoff(const Unit&, int) const { return 0u; }
    int nM, nN, nwg, G, c; const char* Ab; const char* Bb; size_t tstep; unsigned long long tmap;
    __device__ __forceinline__ void init(const void* A, const void* Bt, int M, int N, int K, int G_, int c_) { nM = M / BM; nN = N / BM; nwg = nM * nN; G = G_; c = c_; Ab = (const char*)A; Bb = (const char*)Bt; tstep = (size_t)BM * K * 2; tmap = 0ull; }
    __device__ __forceinline__ bool next(int i, Unit& u) const {
        const long L = (long)i * G + c; if (L >= nwg) return false;
        int wgid = (int)L; { const int q = nwg / NXCD, r = nwg % NXCD, xcd = wgid % NXCD, off = wgid / NXCD; wgid = (xcd < r ? xcd * (q + 1) : r * (q + 1) + (xcd - r) * q) + off; }
        const int nig = WGM * nN, gid = wgid / nig, fm = gid * WGM, gsz = (nM - fm) < WGM ? (nM - fm) : WGM;
        u.pm = fm + ((wgid % nig) % gsz); u.pn = (wgid % nig) / gsz; if (tmap) u.pn = (int)((tmap >> (4 * u.pn)) & 15ull); return true;
    }
    __device__ __forceinline__ const char* A(const Unit& u) const { return Ab + (size_t)u.pm * tstep; }
    __device__ __forceinline__ const char* B(const Unit& u) const { return Bb + (size_t)u.pn * tstep; }
    __device__ __forceinline__ void a_ready(const Unit&) const {}
    __device__ __forceinline__ void done(const Unit&) const {}
    __device__ __forceinline__ int lag() const { return 0; }
};
template <int NT, unsigned TM, int NLO, int NHI> struct SplitOrder {
    static_assert(NLO + NHI == NT, "split");
    static constexpr bool GATHER = false;
    __device__ __forceinline__ unsigned rowoff(const Unit&, int) const { return 0u; }
    int G, c; const char* Ab; const char* Bb; size_t tstep;
    __device__ __forceinline__ bool next(int i, Unit& u) const {
        int L;
        if (G != 256) { const long Lx = (long)i * G + c; if (Lx >= 128 * NT) return false; L = (int)Lx; }
        else if (c >= 128) { if (i >= NHI) return false; L = (c - 128) + 128 * i; }
        else { if (i >= NLO) return false; L = 128 * NHI + c + 128 * i; }
        const int Lr = (L % NXCD) * (16 * NT) + L / NXCD;
        u.pm = Lr / NT; u.pn = (int)((TM >> (4 * (Lr % NT))) & 15u); return true;
    }
    __device__ __forceinline__ const char* A(const Unit& u) const { return Ab + (size_t)u.pm * tstep; }
    __device__ __forceinline__ const char* B(const Unit& u) const { return Bb + (size_t)u.pn * tstep; }
    __device__ __forceinline__ void a_ready(const Unit&) const {}
    __device__ __forceinline__ void done(const Unit&) const {}
    __device__ __forceinline__ int lag() const { return 0; }
};
struct MoeOrder {
    static constexpr bool GATHER = false;
    __device__ __forceinline__ unsigned rowoff(const Unit&, int) const { return 0u; }
    int nN, np, ppx, G, c; const char* Ab; const char* Wb; size_t tstep, estride; const PG8_LAS int* ptab;
    __device__ __forceinline__ void init(int nN_, int np_, int G_, int c_) { nN = nN_; np = np_; G = G_; c = c_; ppx = (np_ + NXCD - 1) / NXCD; }
    __device__ __forceinline__ bool next(int i, Unit& u) const {
        if (G % NXCD != 0) { const long L = (long)i * G + c; if (L >= (long)np * nN) return false; u.pm = (int)L / nN; u.pn = (int)L % nN; return true; }
        const int x = c % NXCD, s = c / NXCD, wpx = G / NXCD, v = i * wpx + s, pl = v / nN;
        const int p0 = x * ppx, pend = (p0 + ppx) < np ? (p0 + ppx) : np;
        if (p0 + pl >= pend) return false;
        u.pm = p0 + pl; u.pn = v % nN; return true;
    }
    __device__ __forceinline__ const char* A(const Unit& u) const { return Ab + (size_t)u.pm * tstep; }
    __device__ __forceinline__ const char* B(const Unit& u) const { const int e = __builtin_amdgcn_readfirstlane(ptab[u.pm]); return Wb + (size_t)e * estride + (size_t)u.pn * tstep; }
    __device__ __forceinline__ void a_ready(const Unit&) const {}
    __device__ __forceinline__ void done(const Unit&) const {}
    __device__ __forceinline__ int lag() const { return (G % NXCD != 0) ? (int)(((long)c * 32) / G) : (int)(((long)(c / NXCD) * 32) / (G / NXCD)); }
};

struct MoeGatherOrder : MoeOrder {
    static constexpr bool GATHER = true;
    const int* rowtok; const PG8_LAS int* off; const PG8_LAS int* cnt; unsigned rowbytes;
    __device__ __forceinline__ const char* A(const Unit&) const { return Ab; }
    __device__ __forceinline__ unsigned rowoff(const Unit& u, int prow) const {
        const int e = __builtin_amdgcn_readfirstlane(ptab[u.pm]); const int valid = __builtin_amdgcn_readfirstlane(cnt[e] - (u.pm * 256 - off[e]));
        const int lrow = __builtin_amdgcn_readfirstlane(u.pm * 256 - off[e]);
        const int tok = (prow < valid) ? rowtok[(size_t)e * 32768 + lrow + prow] : 0;
        return (unsigned)tok * rowbytes;
    }
};

typedef int v8i_t __attribute__((ext_vector_type(8)));
template <class Epi, class Sched, bool ALIGN_EPI = false, bool SP2 = false, bool F8 = false, int STAGGER = 0>
__device__ __forceinline__ void gemm_phase(PG8_LAS unsigned char* lds, const int K, const Sched& S, const Epi& E) {
    int tid_ = threadIdx.x; asm volatile("" : "+v"(tid_)); const int tid = tid_, wid = __builtin_amdgcn_readfirstlane(tid >> 6), lane = tid & 63, wr = wid >> 2, wc = wid & 3, fr = lane & 15, fq = lane >> 4;
    const int nt = K / BK;
    unsigned voffA[2], voffB[2];
    constexpr bool GA = Sched::GATHER;
    int RpA[2]; unsigned CpA[2];
    unsigned cv0[2] = {0u, 0u}, cv1[2] = {0u, 0u}, nv0[2] = {0u, 0u}, nv1[2] = {0u, 0u};
#pragma unroll
    for (int i = 0; i < 2; ++i) { int R, C; stage_rc(tid * 16 + i * 8192, R, C); const int Rb = Epi::BJADJ ? ((R >> 5) * 64 + perm32(R & 31)) : (Epi::PERM ? ((R & ~31) + perm32(R & 31)) : R);
        voffA[i] = (unsigned)(R * K + C) * 2u; voffB[i] = (unsigned)(Rb * K + C) * 2u; RpA[i] = R; CpA[i] = (unsigned)C * 2u; }
    const size_t kstep = (size_t)(BK * 2);
    const size_t hstep = (size_t)HALF * K * 2;
    const size_t hstepB = Epi::BJADJ ? (size_t)32 * K * 2 : hstep;
    const unsigned ldsw = (unsigned)wid * 1024u;
    const int aoff = lds_byte(wr * 64 + fr, fq * 8);
    const int boff = lds_byte(wc * 32 + fr, fq * 8);
    int f8sc = 0x7f7f7f7f; (void)f8sc;
#define PG8_SA(b, h) (((b) * 2 + (h)) * HTB)
#define PG8_SB(b, h) ((4 + (b) * 2 + (h)) * HTB)
#define PG8_STAGE(bufoff, gbase, voff) do { _Pragma("unroll") for (int _i = 0; _i < 2; ++_i) \
        __builtin_amdgcn_global_load_lds((const unsigned*)((const char*)(gbase) + (voff)[_i]), (PG8_LAS unsigned*)(lds + (bufoff) + ldsw + _i * 8192), 16, 0, 0); } while (0)
#define PG8_STA(bufoff, base, half, V0, V1) do { if constexpr (GA) { if (half) PG8_STAGE(bufoff, base, V1); else PG8_STAGE(bufoff, base, V0); } else { PG8_STAGE(bufoff, (base) + ((half) ? hstep : 0), voffA); } } while (0)
#define PG8_GAOFF(u, D0, D1) do { _Pragma("unroll") for (int _i = 0; _i < 2; ++_i) { D0[_i] = S.rowoff(u, RpA[_i]) + CpA[_i]; D1[_i] = S.rowoff(u, HALF + RpA[_i]) + CpA[_i]; } } while (0)
#define PG8_LDA(dst, b, h) do { if constexpr (F8) { _Pragma("unroll") for (int m = 0; m < 4; ++m) { const u32x4 lo_ = *(const PG8_LAS u32x4*)(lds + PG8_SA(b, h) + aoff + m * 2048), hi_ = *(const PG8_LAS u32x4*)(lds + PG8_SA(b, h) + aoff + m * 2048 + 1024); dst##8[m] = (v8i_t){(int)lo_.x, (int)lo_.y, (int)lo_.z, (int)lo_.w, (int)hi_.x, (int)hi_.y, (int)hi_.z, (int)hi_.w}; } } else { _Pragma("unroll") for (int m = 0; m < 4; ++m) _Pragma("unroll") for (int k = 0; k < 2; ++k) dst[m][k] = *(const PG8_LAS bf16x8*)(lds + PG8_SA(b, h) + aoff + m * 2048 + k * 1024); } } while (0)
#define PG8_LDB(dst, b, h) do { if constexpr (F8) { _Pragma("unroll") for (int n = 0; n < 2; ++n) { const u32x4 lo_ = *(const PG8_LAS u32x4*)(lds + PG8_SB(b, h) + boff + n * 2048), hi_ = *(const PG8_LAS u32x4*)(lds + PG8_SB(b, h) + boff + n * 2048 + 1024); dst##8[n] = (v8i_t){(int)lo_.x, (int)lo_.y, (int)lo_.z, (int)lo_.w, (int)hi_.x, (int)hi_.y, (int)hi_.z, (int)hi_.w}; } } else { _Pragma("unroll") for (int n = 0; n < 2; ++n) _Pragma("unroll") for (int k = 0; k < 2; ++k) dst[n][k] = *(const PG8_LAS bf16x8*)(lds + PG8_SB(b, h) + boff + n * 2048 + k * 1024); } } while (0)
#define PG8_MMA(ai, bj, At, Bt) do { __builtin_amdgcn_s_setprio(1); if constexpr (F8) { _Pragma("unroll") for (int m = 0; m < 4; ++m) _Pragma("unroll") for (int n = 0; n < 2; ++n) \
        asm volatile("v_mfma_scale_f32_16x16x128_f8f6f4 %0, %1, %2, %0, %3, %3 op_sel_hi:[0,0,0]" : "+v"(acc[ai][bj][m][n]) : "v"(Bt##8[n]), "v"(At##8[m]), "v"(f8sc)); } \
        else { _Pragma("unroll") for (int m = 0; m < 4; ++m) _Pragma("unroll") for (int n = 0; n < 2; ++n) _Pragma("unroll") for (int k = 0; k < 2; ++k) \
        acc[ai][bj][m][n] = __builtin_amdgcn_mfma_f32_16x16x32_bf16(Bt[n][k], At[m][k], acc[ai][bj][m][n], 0, 0, 0); } __builtin_amdgcn_s_setprio(0); } while (0)
#define PG8_WAIT_V(n) asm volatile("s_waitcnt vmcnt(" #n ")" ::: "memory")
#define PG8_WAIT_L(n) asm volatile("s_waitcnt lgkmcnt(" #n ")" ::: "memory")
#define PG8_BAR __builtin_amdgcn_s_barrier()
#define PG8_SCHED __builtin_amdgcn_sched_barrier(0)
    Unit cur, nxt; int ui = 0;
    if (!S.next(0, cur)) return;
    if constexpr (STAGGER > 0) { const int lg_ = __builtin_amdgcn_readfirstlane(S.lag()); for (int q = 0; q < lg_; ++q) __builtin_amdgcn_s_sleep(STAGGER); }
    f32x4 acc[2][2][4][2];
#pragma unroll
    for (int a = 0; a < 2; ++a)
#pragma unroll
        for (int b = 0; b < 2; ++b)
#pragma unroll
            for (int m = 0; m < 4; ++m)
#pragma unroll
                for (int n = 0; n < 2; ++n) acc[a][b][m][n] = (f32x4){0.f, 0.f, 0.f, 0.f};
    if constexpr (F8) { PG8_SCHED; asm volatile("s_nop 7" ::: "memory"); PG8_SCHED; }
    bf16x8 At[4][2], B0[2][2], B1[2][2];
    v8i_t At8[4], B08[2], B18[2];
    const char* cA = S.A(cur); const char* cB = S.B(cur);
    if constexpr (GA) PG8_GAOFF(cur, cv0, cv1);
    S.a_ready(cur);
    if constexpr (SP2) {
        PG8_STAGE(PG8_SB(0, 0), cB, voffB); PG8_STAGE(PG8_SB(0, 1), cB + hstepB, voffB); PG8_STA(PG8_SA(0, 0), cA, 0, cv0, cv1); PG8_STA(PG8_SA(0, 1), cA, 1, cv0, cv1);
        if (wr == 1) PG8_BAR;
        PG8_WAIT_V(2); PG8_BAR;
        PG8_STAGE(PG8_SB(1, 0), cB + kstep, voffB); PG8_STA(PG8_SA(1, 0), cA + kstep, 0, cv0, cv1); PG8_STAGE(PG8_SB(1, 1), cB + hstepB + kstep, voffB);
        PG8_WAIT_V(6); PG8_BAR;
    } else {
        PG8_STAGE(PG8_SB(0, 0), cB, voffB); PG8_STAGE(PG8_SA(0, 0), cA, voffA); PG8_STAGE(PG8_SB(0, 1), cB + hstepB, voffB); PG8_STAGE(PG8_SA(0, 1), cA + hstep, voffA);
        if (wr == 1) PG8_BAR;
        PG8_WAIT_V(4); PG8_BAR;
        PG8_STAGE(PG8_SB(1, 0), cB + kstep, voffB); PG8_STAGE(PG8_SA(1, 0), cA + kstep, voffA); PG8_STAGE(PG8_SB(1, 1), cB + hstepB + kstep, voffB);
        PG8_WAIT_V(6); PG8_BAR;
    }
    for (;;) {
        const bool has_next = S.next(ui + 1, nxt);
        const char* nA = has_next ? S.A(nxt) : cA; const char* nB = has_next ? S.B(nxt) : cB;
        if constexpr (GA) { if (has_next) PG8_GAOFF(nxt, nv0, nv1); else { nv0[0] = cv0[0]; nv0[1] = cv0[1]; nv1[0] = cv1[0]; nv1[1] = cv1[1]; } }
#pragma unroll 1
        for (int t = 0; t < nt; t += 2) {
            const bool last = (t == nt - 2);
            const char* a1 = cA + (size_t)(t + 1) * kstep;
            const char* a2 = last ? nA : cA + (size_t)(t + 2) * kstep; const char* b2 = last ? nB : cB + (size_t)(t + 2) * kstep;
            const char* a3 = a2 + kstep; const char* b3 = b2 + kstep;
            if (last && has_next) S.a_ready(nxt);
            unsigned sv0[2] = {0u, 0u}, sv1[2] = {0u, 0u};
            if constexpr (GA) { sv0[0] = last ? nv0[0] : cv0[0]; sv0[1] = last ? nv0[1] : cv0[1]; sv1[0] = last ? nv1[0] : cv1[0]; sv1[1] = last ? nv1[1] : cv1[1]; }
            if constexpr (SP2) {
            PG8_LDB(B0, 0, 0); PG8_LDB(B1, 0, 1); PG8_SCHED; PG8_LDA(At, 0, 0); PG8_STA(PG8_SA(1, 1), a1, 1, cv0, cv1);
            PG8_WAIT_V(8); PG8_WAIT_L(0); PG8_BAR; PG8_MMA(0, 0, At, B0); PG8_MMA(0, 1, At, B1); PG8_BAR; PG8_SCHED;
            PG8_LDA(At, 0, 1); PG8_STAGE(PG8_SB(0, 0), b2, voffB); PG8_STAGE(PG8_SB(0, 1), b2 + hstepB, voffB); PG8_STA(PG8_SA(0, 0), a2, 0, sv0, sv1);
            PG8_WAIT_V(8); PG8_WAIT_L(0); PG8_BAR; PG8_MMA(1, 0, At, B0); PG8_MMA(1, 1, At, B1); PG8_BAR; PG8_SCHED;
            PG8_LDB(B0, 1, 0); PG8_LDB(B1, 1, 1); PG8_SCHED; PG8_LDA(At, 1, 0); PG8_STA(PG8_SA(0, 1), a2, 1, sv0, sv1);
            PG8_WAIT_V(8); PG8_WAIT_L(0); PG8_BAR; PG8_MMA(0, 0, At, B0); PG8_MMA(0, 1, At, B1); PG8_BAR; PG8_SCHED;
            PG8_LDA(At, 1, 1); PG8_STAGE(PG8_SB(1, 0), b3, voffB); PG8_STAGE(PG8_SB(1, 1), b3 + hstepB, voffB); PG8_STA(PG8_SA(1, 0), a3, 0, sv0, sv1);
            PG8_WAIT_V(8); PG8_WAIT_L(0); PG8_BAR; PG8_MMA(1, 0, At, B0); PG8_MMA(1, 1, At, B1); PG8_BAR; PG8_SCHED;
            } else {
            PG8_LDB(B0, 0, 0); PG8_SCHED; PG8_LDA(At, 0, 0); PG8_STAGE(PG8_SA(1, 1), a1 + hstep, voffA);
            PG8_WAIT_L(8); PG8_BAR; PG8_WAIT_L(0); PG8_MMA(0, 0, At, B0); PG8_BAR; PG8_SCHED;
            PG8_LDB(B1, 0, 1); PG8_STAGE(PG8_SB(0, 0), b2, voffB);
            PG8_BAR; PG8_WAIT_L(0); PG8_MMA(0, 1, At, B1); PG8_BAR;
            PG8_LDA(At, 0, 1); PG8_STAGE(PG8_SA(0, 0), a2, voffA);
            PG8_BAR; PG8_WAIT_L(0); PG8_MMA(1, 0, At, B0); PG8_BAR; PG8_SCHED;
            PG8_STAGE(PG8_SB(0, 1), b2 + hstepB, voffB);
            PG8_WAIT_V(6); PG8_BAR; PG8_MMA(1, 1, At, B1); PG8_BAR;
            PG8_LDB(B0, 1, 0); PG8_SCHED; PG8_LDA(At, 1, 0); PG8_STAGE(PG8_SA(0, 1), a2 + hstep, voffA);
            PG8_WAIT_L(8); PG8_BAR; PG8_WAIT_L(0); PG8_MMA(0, 0, At, B0); PG8_BAR; PG8_SCHED;
            PG8_LDB(B1, 1, 1); PG8_STAGE(PG8_SB(1, 0), b3, voffB);
            PG8_BAR; PG8_WAIT_L(0); PG8_MMA(0, 1, At, B1); PG8_BAR;
            PG8_LDA(At, 1, 1); PG8_STAGE(PG8_SA(1, 0), a3, voffA);
            PG8_BAR; PG8_WAIT_L(0); PG8_MMA(1, 0, At, B0); PG8_BAR; PG8_SCHED;
            PG8_STAGE(PG8_SB(1, 1), b3 + hstepB, voffB);
            PG8_WAIT_V(6); PG8_BAR; PG8_MMA(1, 1, At, B1); PG8_BAR;
            }
        }
        if constexpr (F8) { PG8_SCHED; asm volatile("s_nop 15\n\ts_nop 15" ::: "memory"); PG8_SCHED; }
        if constexpr (ALIGN_EPI) { if (wr == 0) PG8_BAR; }
        if constexpr (!Epi::AFTER_DRAIN) { E(acc, cur, wr, wc, fr, fq); S.done(cur); }
        if (!has_next) break;
#pragma unroll
        for (int a = 0; a < 2; ++a)
#pragma unroll
            for (int b = 0; b < 2; ++b)
#pragma unroll
                for (int m = 0; m < 4; ++m)
#pragma unroll
                    for (int n = 0; n < 2; ++n) acc[a][b][m][n] = (f32x4){0.f, 0.f, 0.f, 0.f};
        if constexpr (F8) { PG8_SCHED; asm volatile("s_nop 7" ::: "memory"); PG8_SCHED; }
        cur = nxt; cA = nA; cB = nB; ++ui;
        if constexpr (GA) { cv0[0] = nv0[0]; cv0[1] = nv0[1]; cv1[0] = nv1[0]; cv1[1] = nv1[1]; }
        if constexpr (ALIGN_EPI) { if (wr == 1) PG8_BAR; }
    }
    PG8_WAIT_V(0);
    if constexpr (!ALIGN_EPI) { if (wr == 0) PG8_BAR; }
    PG8_BAR;
    if constexpr (Epi::AFTER_DRAIN) { E.fused(acc, cur, wr, wc, fr, fq, lds, wid, lane); S.done(cur); }
#undef PG8_SA
#undef PG8_SB
#undef PG8_STAGE
#undef PG8_STA
#undef PG8_GAOFF
#undef PG8_LDA
#undef PG8_LDB
#undef PG8_MMA
#undef PG8_WAIT_V
#undef PG8_WAIT_L
#undef PG8_BAR
#undef PG8_SCHED
}
}

constexpr int NWAVES = 8, NTHR = 512;
constexpr int NB = 8, T = 4096, D = 1024, M = NB * T, DEPTH = 2;
constexpr int INW = 3656, NP = 3840;
constexpr int NE = 32, FF = 1024;
constexpr float LN_EPS = 1e-5f, ALPHA_RES = 1.41421356237f;
constexpr int C_AQ = 0, C_AK = 256, C_AV = 512, C_RQ = 768, C_RK = 1024, C_RV = 1280, C_RG = 1536, C_CX = 1792, C_CG = 2048, C_DQ = 2304, C_DK = 2560, C_DV = 2816, C_QI = 3072, C_KI = 3584, C_W = 3648;
constexpr int MAXPANELS = 544;
constexpr int MAXROWS = MAXPANELS * 256;

constexpr size_t MiB = 1u << 20;
constexpr size_t WS_CTL = 0, CTL_ZERO_BYTES = 1 * MiB;
constexpr size_t WS_WIN = 1 * MiB;
constexpr size_t WS_WOUT = WS_WIN + 15 * MiB;
constexpr size_t WS_W1 = WS_WOUT + 4 * MiB;
constexpr size_t WS_W2 = WS_W1 + 256 * MiB;
constexpr size_t WS_ROPE = WS_W2 + 128 * MiB;
constexpr size_t WS_XB = WS_ROPE + 1 * MiB;
constexpr size_t WS_XF = WS_XB + 64 * MiB;
constexpr size_t WS_X8 = WS_XF;
constexpr size_t WS_WIN8 = WS_XF + 64 * MiB;
constexpr size_t WS_Y1 = WS_XF + 128 * MiB;
constexpr size_t WS_X1B = WS_Y1 + 128 * MiB;
constexpr size_t WS_LNS = WS_X1B;
constexpr size_t WS_MIX = WS_X1B + 64 * MiB;
constexpr size_t WS_PJ = WS_MIX + 64 * MiB;
constexpr size_t WS_SC = WS_PJ + 272 * MiB;
constexpr size_t WS_XP = WS_SC, WS_G = WS_SC + 272 * MiB;
constexpr size_t WS_ROWTOK = WS_XP;
constexpr size_t WS_X1Q = WS_XP + 8 * MiB;
constexpr int RT2_CAP = 32768;
constexpr size_t WS_MASK = WS_SC + 544 * MiB;
constexpr size_t WS_HLOC = WS_MASK + 16 * MiB;
constexpr size_t WS_PC = WS_HLOC + 32 * MiB;
constexpr size_t WS_RGS = WS_PC + 32 * MiB;
constexpr size_t WS_ST = WS_RGS + 2 * MiB;
constexpr size_t WS_RT = WS_ST + 16 * MiB;
constexpr size_t WS_KMB = WS_RT + 8 * MiB;
constexpr size_t WS_KN2 = WS_KMB + 256 * 1024;
constexpr size_t WS_RWB = WS_KMB + 512 * 1024;
constexpr size_t WS_RGW = WS_KMB + 768 * 1024;
constexpr size_t WS_TOK = WS_KMB + 1 * MiB;
constexpr size_t WS_END = WS_TOK + 2 * MiB;
static_assert(INW % 8 == 0, "padding-column test in EpiProj");
static_assert(WS_END <= (size_t)2048 * MiB, "d_ws map exceeds 2 GiB");
constexpr int CW_BAR = 4096;
constexpr int CW_CNT = 16384;

constexpr int RING_BYTES = 131072;
constexpr int LDSCTL_OFF = RING_BYTES;
constexpr int LC_MISC = 0;
constexpr int LC_OFF = 256;
constexpr int LC_CNT = 2816;
constexpr int LC_PTAB = 512;
constexpr int LC_WCNT = 3072;
constexpr int LC_HIST = 4096;
constexpr int LC_REC = 4096;
constexpr int LDS_BYTES = 163840;
constexpr int LDS_LG_OFF = 147456;

#define GAS __attribute__((address_space(1)))
#define LAS __attribute__((address_space(3)))
typedef unsigned short bf16;
typedef unsigned v4u __attribute__((ext_vector_type(4)));
typedef unsigned v2u __attribute__((ext_vector_type(2)));
typedef float f32x4 __attribute__((ext_vector_type(4)));
typedef float f32x2 __attribute__((ext_vector_type(2)));
typedef float f32x16 __attribute__((ext_vector_type(16)));
typedef short bf16x8 __attribute__((ext_vector_type(8)));
typedef GAS unsigned gu32;
#define RLX_AGENT __ATOMIC_RELAXED, __HIP_MEMORY_SCOPE_AGENT
#define LDS_WAIT() asm volatile("s_waitcnt lgkmcnt(0)" ::: "memory")
#define VM_WAIT() asm volatile("s_waitcnt vmcnt(0)" ::: "memory")
__device__ __forceinline__ float bf2f(bf16 b) { return __uint_as_float((unsigned)b << 16); }
__device__ __forceinline__ float bflo(unsigned w) { return __uint_as_float(w << 16); }
__device__ __forceinline__ float bfhi(unsigned w) { return __uint_as_float(w & 0xffff0000u); }
typedef float f32x2_cv __attribute__((ext_vector_type(2)));
typedef __bf16 bf16x2_cv __attribute__((ext_vector_type(2)));
__device__ __forceinline__ unsigned pk2(float lo, float hi) { const f32x2_cv v = {lo, hi}; const bf16x2_cv b = __builtin_convertvector(v, bf16x2_cv); return __builtin_bit_cast(unsigned, b); }
__device__ __forceinline__ float wave_sum(float v) {
#pragma unroll
    for (int o = 1; o < 64; o <<= 1) v += __shfl_xor(v, o);
    return v;
}
__device__ __forceinline__ int wave_sum_i(int v) {
#pragma unroll
    for (int o = 1; o < 64; o <<= 1) v += __shfl_xor(v, o);
    return v;
}
__device__ __forceinline__ int wave_prefix_incl(int x) {
    x += __builtin_amdgcn_update_dpp(0, x, 0x111, 0xf, 0xf, true);
    x += __builtin_amdgcn_update_dpp(0, x, 0x112, 0xf, 0xf, true);
    x += __builtin_amdgcn_update_dpp(0, x, 0x114, 0xf, 0xf, true);
    x += __builtin_amdgcn_update_dpp(0, x, 0x118, 0xf, 0xf, true);
    x += __builtin_amdgcn_update_dpp(0, x, 0x142, 0xa, 0xf, false);
    x += __builtin_amdgcn_update_dpp(0, x, 0x143, 0xc, 0xf, false);
    return x;
}
constexpr float SC_X8 = 16.0f, SC_W8 = 2048.0f, SC_G8 = 4.0f, SC_M8 = 16.0f;
#ifndef P1_F8
#define P1_F8 1
#endif
#ifndef P1_F8_NT
#define P1_F8_NT 6
#endif
#if P1_F8_NT == 6
#define P1_F8_TM 0xB87652u
#define P1_F8_SET 0x9E4u
#define P1_BF_TM 0xEDCA94310ull
#define P1_F8_NLO 2
#define P1_F8_NHI 4
#else
#define P1_F8_TM 0xB652u
#define P1_F8_SET 0x864u
#define P1_BF_TM 0xEDCA9874310ull
#define P1_F8_NLO 1
#define P1_F8_NHI 3
#endif
constexpr int P1_BF_NT = 15 - P1_F8_NT;
#ifndef P6_F8
#define P6_F8 0
#endif
__device__ __forceinline__ float sat8(float x) { return fminf(fmaxf(x, -448.0f), 448.0f); }
__device__ __forceinline__ unsigned pk4_fp8(float a, float b, float c, float d) { int p = __builtin_amdgcn_cvt_pk_fp8_f32(sat8(a), sat8(b), 0, false); p = __builtin_amdgcn_cvt_pk_fp8_f32(sat8(c), sat8(d), p, true); return (unsigned)p; }
__device__ __forceinline__ f32x4 mfma16(bf16x8 a, bf16x8 b, f32x4 c) { return __builtin_amdgcn_mfma_f32_16x16x32_bf16(a, b, c, 0, 0, 0); }
__device__ __forceinline__ float sigmoidf_(float x) { return __builtin_amdgcn_rcpf(1.f + __builtin_amdgcn_exp2f(-1.4426950408889634f * x)); }
#define XB_TMO      128
#define XB_XCNT(j)  (256  + 64 * (j))
#define XB_XSUB(j)  (1280 + 64 * (j))
#define XB_XGEN(j)  (2304 + 64 * (j))
#define XB_TOP      3328
#define XB_TOPGEN   3392
#define XCD_BAR_WORDS 3456
#define XB_SPIN_CAP (1u << 18)

__device__ __forceinline__ unsigned xb_ld(unsigned* p)              { return __hip_atomic_load(p, __ATOMIC_RELAXED, __HIP_MEMORY_SCOPE_AGENT); }
__device__ __forceinline__ unsigned xb_add(unsigned* p, unsigned v) { return __hip_atomic_fetch_add(p, v, __ATOMIC_RELAXED, __HIP_MEMORY_SCOPE_AGENT); }
__device__ __forceinline__ unsigned xb_xcc_id() { return (unsigned)__builtin_amdgcn_s_getreg((3 << 11) | 20) & 0xFu; }
#define XB_SPIN(cond, bar) do { unsigned _sp = 0; while (cond) { __builtin_amdgcn_s_sleep(1); \
    if ((++_sp & 255u) == 0u) { if (xb_ld(&(bar)[XB_TMO])) break; if (_sp > XB_SPIN_CAP) { atomicAdd(&(bar)[XB_TMO], 1u); break; } } } } while (0)

struct XcdBarrier {
    unsigned* bar; unsigned x;
    volatile LAS unsigned* st;
};

__device__ __forceinline__ XcdBarrier xcd_barrier_post(unsigned* bar, volatile LAS unsigned* st) {
    XcdBarrier b; b.bar = bar; b.x = xb_xcc_id(); b.st = st;
    if (threadIdx.x == 0) (void)xb_add(&bar[XB_XCNT(b.x)], 1u);
    return b;
}
__device__ __forceinline__ void xcd_barrier_complete(unsigned* bar, unsigned x, unsigned& nloc, unsigned& nx) {
    const unsigned G = gridDim.x * gridDim.y * gridDim.z;
    unsigned sum, cnt, mine, sp = 0u;
    for (;;) {
        sum = 0u; cnt = 0u; mine = 0u;
#pragma unroll
        for (unsigned j = 0; j < 16; ++j) { const unsigned c = xb_ld(&bar[XB_XCNT(j)]); sum += c; cnt += (c > 0u) ? 1u : 0u; mine = (j == x) ? c : mine; }
        if (sum == G) break;
        __builtin_amdgcn_s_sleep(1);
        if ((++sp & 255u) == 0u) { if (xb_ld(&bar[XB_TMO])) break; if (sp > XB_SPIN_CAP) { atomicAdd(&bar[XB_TMO], 1u); break; } }
    }
    nloc = mine > 0u ? mine : 1u; nx = cnt > 0u ? cnt : 1u;
}

__device__ __forceinline__ void xcd_barrier(const XcdBarrier& b) {
    asm volatile("s_waitcnt vmcnt(0)" ::: "memory");
    __syncthreads();
    if (threadIdx.x == 0) {
        unsigned* bar = b.bar;
        __builtin_amdgcn_s_waitcnt(0);
        unsigned nloc = b.st[0], nx = b.st[1];
        if (nloc == 0u) { xcd_barrier_complete(bar, b.x, nloc, nx); b.st[0] = nloc; b.st[1] = nx; }
        const unsigned old = xb_add(&bar[XB_XSUB(b.x)], 1u);
        const unsigned gen = old / nloc;
        if (old + 1u == (gen + 1u) * nloc) {
            __builtin_amdgcn_fence(__ATOMIC_RELEASE, "agent");
            asm volatile("s_waitcnt vmcnt(0)" ::: "memory");
            const unsigned og = xb_add(&bar[XB_TOP], 1u);
            const unsigned tg = og / nx;
            if (og + 1u == (tg + 1u) * nx) xb_add(&bar[XB_TOPGEN], 1u);
            else XB_SPIN(xb_ld(&bar[XB_TOPGEN]) == tg, bar);
            __builtin_amdgcn_fence(__ATOMIC_ACQUIRE, "agent");
            xb_add(&bar[XB_XGEN(b.x)], 1u);
            asm volatile("s_waitcnt vmcnt(0)" ::: "memory");
        } else {
            XB_SPIN(xb_ld(&bar[XB_XGEN(b.x)]) == gen, bar);
            __builtin_amdgcn_fence(__ATOMIC_ACQUIRE, "agent");
            asm volatile("s_waitcnt vmcnt(0)" ::: "memory");
        }
    }
    __syncthreads();
}

struct Args { const float* in[22]; float* out; unsigned char* ws; int ph_lo, ph_hi; };
struct Frame {
    LAS unsigned char* lds;
    LAS unsigned char* lctl;
    gu32* ctl;
    unsigned char* ws;
    int G, bid, layer;
};
__device__ __forceinline__ int ltid() { int t = threadIdx.x; asm volatile("" : "+v"(t)); return t; }
__device__ __forceinline__ const void* launder_uniform(const void* p) {
    unsigned lo = (unsigned)(unsigned long long)p, hi = (unsigned)((unsigned long long)p >> 32);
    asm volatile("" : "+v"(lo), "+v"(hi));
    lo = __builtin_amdgcn_readfirstlane(lo); hi = __builtin_amdgcn_readfirstlane(hi);
    return (const void*)(const __attribute__((address_space(1))) char*)(((unsigned long long)hi << 32) | lo);
}
typedef const __attribute__((address_space(4))) Args* KArgs;
__device__ __forceinline__ KArgs launder_kargs() {
    const unsigned long long p = (unsigned long long)__builtin_amdgcn_kernarg_segment_ptr();
    unsigned lo = (unsigned)p, hi = (unsigned)(p >> 32);
    asm volatile("" : "+v"(lo), "+v"(hi));
    lo = __builtin_amdgcn_readfirstlane(lo); hi = __builtin_amdgcn_readfirstlane(hi);
    return (KArgs)(((unsigned long long)hi << 32) | lo);
}
__device__ __forceinline__ int launder_i(int x) { asm volatile("" : "+v"(x)); return __builtin_amdgcn_readfirstlane(x); }
#define PH_PTRS unsigned char* wsl = (unsigned char*)launder_uniform(F.ws); KArgs Al = launder_kargs(); const int G_ = launder_i(F.G), bid_ = launder_i(F.bid); (void)Al; (void)G_; (void)bid_; (void)wsl
#define PH_IDS PH_PTRS; const int tid = ltid(), lane = tid & 63, w = __builtin_amdgcn_readfirstlane(tid >> 6); (void)lane; (void)w
#define LIN(i, stride) ((const float*)((const __attribute__((address_space(1))) float*)Al->in[i] + (size_t)F.layer * (stride)))
#define WSP(T_, off) ((T_*)(wsl + (off)))

struct EpiProj {
    static constexpr bool PERM = true, AFTER_DRAIN = false, BJADJ = false;
    bf16* O; const f32x2* cs; float dq;
#ifdef PROBE_EPI
    int skip;
#endif
    __device__ __forceinline__ void operator()(const pg8::f32x4 (&acc)[2][2][4][2], const pg8::Unit& u, int wr, int wc, int fr, int fq) const {
#ifdef PROBE_EPI
        if (skip) { if (acc[0][0][0][0][0] == 1.2345e-30f) O[0] = 0; return; }
#endif
        const int row0 = u.pm * 256 + wr * 64 + fr;
        const int colb = u.pn * 256 + wc * 32 + 8 * fq;
        const int i0 = (colb & 63) >> 1;
        const int colw = __builtin_amdgcn_readfirstlane(u.pn * 256 + wc * 32);
        bool ropeb[2]; float scb[2];
#pragma unroll
        for (int bj = 0; bj < 2; ++bj) { const int c0 = colw + bj * 128;
            ropeb[bj] = (c0 < 512) || (c0 >= 768 && c0 < 1280) || (c0 >= 2304 && c0 < 2816) || (c0 >= 3072 && c0 < 3648);
            scb[bj] = dq * (((c0 < 256) || (c0 >= 2304 && c0 < 2560)) ? 0.18033688011112042f   : ((c0 >= 1024 && c0 < 1280) ? 0.125f : 1.0f)); }
        f32x4 c01[2][4], c23[2][4];
        if (ropeb[0] || ropeb[1]) {
#pragma unroll
            for (int ai = 0; ai < 2; ++ai)
#pragma unroll
                for (int m = 0; m < 4; ++m) { const f32x4* cp = (const f32x4*)(cs + (size_t)((row0 + ai * 128 + m * 16) & (T - 1)) * 32 + i0); c01[ai][m] = cp[0]; c23[ai][m] = cp[1]; }
        }
#pragma unroll
        for (int bj = 0; bj < 2; ++bj) {
            const int col0 = colb + bj * 128;
            const float sc = scb[bj];
            if (ropeb[bj]) {
#pragma unroll
                for (int ai = 0; ai < 2; ++ai)
#pragma unroll
                    for (int m = 0; m < 4; ++m) {
                        const int row = row0 + ai * 128 + m * 16;
                        const pg8::f32x4 v0 = acc[ai][bj][m][0], v1 = acc[ai][bj][m][1];
                        const f32x4 ca = c01[ai][m] * sc, cb = c23[ai][m] * sc;
                        pg8::f32x4 o0, o1;
                        o0[0] = v0[0] * ca[0] - v0[1] * ca[1]; o0[1] = v0[1] * ca[0] + v0[0] * ca[1];
                        o0[2] = v0[2] * ca[2] - v0[3] * ca[3]; o0[3] = v0[3] * ca[2] + v0[2] * ca[3];
                        o1[0] = v1[0] * cb[0] - v1[1] * cb[1]; o1[1] = v1[1] * cb[0] + v1[0] * cb[1];
                        o1[2] = v1[2] * cb[2] - v1[3] * cb[3]; o1[3] = v1[3] * cb[2] + v1[2] * cb[3];
                        pg8::u32x4 w; w.x = pk2(o0[0], o0[1]); w.y = pk2(o0[2], o0[3]); w.z = pk2(o1[0], o1[1]); w.w = pk2(o1[2], o1[3]);
                        *(pg8::u32x4*)(O + (size_t)row * NP + col0) = w;
                    }
            } else {
#pragma unroll
                for (int ai = 0; ai < 2; ++ai)
#pragma unroll
                    for (int m = 0; m < 4; ++m) {
                        const int row = row0 + ai * 128 + m * 16;
                        const pg8::f32x4 v0 = acc[ai][bj][m][0] * sc, v1 = acc[ai][bj][m][1] * sc;
                        pg8::u32x4 w; w.x = pk2(v0[0], v0[1]); w.y = pk2(v0[2], v0[3]); w.z = pk2(v1[0], v1[1]); w.w = pk2(v1[2], v1[3]);
                        if (col0 < INW) *(pg8::u32x4*)(O + (size_t)row * NP + col0) = w;
                    }
            }
        }
    }
};
struct EpiRes {
    static constexpr bool PERM = true, AFTER_DRAIN = false, BJADJ = true;
    const bf16* X; bf16* Y;
#ifdef PROBE_EPI
    int skip;
#endif
    __device__ __forceinline__ void operator()(const pg8::f32x4 (&acc)[2][2][4][2], const pg8::Unit& u, int wr, int wc, int fr, int fq) const {
#ifdef PROBE_EPI
        if (skip) { if (acc[0][0][0][0][0] == 1.2345e-30f) Y[0] = 0; return; }
#endif
        const int row0 = u.pm * 256 + wr * 64 + fr;
        const int colb = u.pn * 256 + wc * 64 + 8 * fq;
        v4u xh[2][4][2];
#pragma unroll
        for (int ai = 0; ai < 2; ++ai)
#pragma unroll
            for (int m = 0; m < 4; ++m)
#pragma unroll
                for (int bj = 0; bj < 2; ++bj) xh[ai][m][bj] = __builtin_nontemporal_load((const v4u*)(X + (size_t)(row0 + ai * 128 + m * 16) * D + colb + bj * 32));
#pragma unroll
        for (int ai = 0; ai < 2; ++ai)
#pragma unroll
            for (int m = 0; m < 4; ++m)
#pragma unroll
                for (int bj = 0; bj < 2; ++bj) { bf16* yp = Y + (size_t)(row0 + ai * 128 + m * 16) * D + colb + bj * 32;
                    const v4u h = xh[ai][m][bj];
                    const f32x4 x0 = {bflo(h.x), bfhi(h.x), bflo(h.y), bfhi(h.y)}, x1 = {bflo(h.z), bfhi(h.z), bflo(h.w), bfhi(h.w)};
                    constexpr float DQ = P6_F8 ? 1.0f / (SC_M8 * SC_W8) : 1.0f;
                    const f32x4 v0 = x0 * ALPHA_RES + acc[ai][bj][m][0] * DQ, v1 = x1 * ALPHA_RES + acc[ai][bj][m][1] * DQ;
                    pg8::u32x4 wv; wv.x = pk2(v0[0], v0[1]); wv.y = pk2(v0[2], v0[3]); wv.z = pk2(v1[0], v1[1]); wv.w = pk2(v1[2], v1[3]);
                    *(pg8::u32x4*)yp = wv; }
    }
};
struct EpiSwiglu {
    static constexpr bool PERM = true, AFTER_DRAIN = false, BJADJ = false;
    unsigned char* Gm; const float* b1; const LAS int* ptab;
#ifdef PROBE_EPI
    int skip;
#endif
    __device__ __forceinline__ void operator()(const pg8::f32x4 (&acc)[2][2][4][2], const pg8::Unit& u, int wr, int wc, int fr, int fq) const {
#ifdef PROBE_EPI
        if (skip) { if (acc[0][0][0][0][0] == 1.2345e-30f) Gm[0] = 0; return; }
#endif
        const int row0 = u.pm * 256 + wr * 64 + fr;
        const int e = __builtin_amdgcn_readfirstlane(ptab[u.pm]);
        const float* be = b1 + (size_t)e * 2048;
        const int j0 = u.pn * 128 + wc * 32 + 8 * fq;
        const f32x4 bg0 = *(const f32x4*)(be + j0), bg1 = *(const f32x4*)(be + j0 + 4), bu0 = *(const f32x4*)(be + 1024 + j0), bu1 = *(const f32x4*)(be + 1024 + j0 + 4);
        constexpr float DQ = 1.0f / (SC_X8 * SC_W8), DQU = DQ * SC_G8, CE = -1.702f * 1.4426950408889634f;
        static_assert(SC_G8 == 4.0f, "the folded clip bounds assume SC_G8 = 4");
        f32x2 bgp[4] = {{bg0[0], bg0[1]}, {bg0[2], bg0[3]}, {bg1[0], bg1[1]}, {bg1[2], bg1[3]}};
        f32x2 bup[4] = {{bu0[0] * SC_G8, bu0[1] * SC_G8}, {bu0[2] * SC_G8, bu0[3] * SC_G8}, {bu1[0] * SC_G8, bu1[1] * SC_G8}, {bu1[2] * SC_G8, bu1[3] * SC_G8}};
#pragma unroll
        for (int ai = 0; ai < 2; ++ai)
#pragma unroll
            for (int m = 0; m < 4; ++m) {
                const int row = row0 + ai * 128 + m * 16;
                f32x2 o[4];
#pragma unroll
                for (int pq = 0; pq < 4; ++pq) {
                    const int n = pq >> 1, k = 2 * (pq & 1);
                    const f32x2 ag = {acc[ai][0][m][n][k], acc[ai][0][m][n][k + 1]}, au = {acc[ai][1][m][n][k], acc[ai][1][m][n][k + 1]};
                    const f32x2 hg = ag * DQ + bgp[pq];
                    const f32x2 gi = {fminf(hg.x, 7.0f), fminf(hg.y, 7.0f)};
                    const f32x2 ea = gi * CE;
                    const f32x2 den = (f32x2){__builtin_amdgcn_exp2f(ea.x), __builtin_amdgcn_exp2f(ea.y)} + 1.0f;
                    const f32x2 gs = gi * (f32x2){__builtin_amdgcn_rcpf(den.x), __builtin_amdgcn_rcpf(den.y)};
                    const f32x2 hu = au * DQU + bup[pq];
                    const f32x2 up = {__builtin_amdgcn_fmed3f(hu.x, -28.0f, 28.0f), __builtin_amdgcn_fmed3f(hu.y, -28.0f, 28.0f)};
                    o[pq] = (up + SC_G8) * gs;
                }
                v2u w;
                { int p0 = __builtin_amdgcn_cvt_pk_fp8_f32(o[0].x, o[0].y, 0, false); p0 = __builtin_amdgcn_cvt_pk_fp8_f32(o[1].x, o[1].y, p0, true);
                  int p1 = __builtin_amdgcn_cvt_pk_fp8_f32(o[2].x, o[2].y, 0, false); p1 = __builtin_amdgcn_cvt_pk_fp8_f32(o[3].x, o[3].y, p1, true); w.x = (unsigned)p0; w.y = (unsigned)p1; }
                *(v2u*)(Gm + (size_t)row * FF + j0) = w;
            }
    }
};
struct EpiBias {
    static constexpr bool PERM = true, AFTER_DRAIN = false, BJADJ = true;
    bf16* Y; const float* b2; const LAS int* ptab;
#ifdef PROBE_EPI
    int skip; bf16* Y2;
#endif
    __device__ __forceinline__ void operator()(const pg8::f32x4 (&acc)[2][2][4][2], const pg8::Unit& u, int wr, int wc, int fr, int fq) const {
#ifdef PROBE_EPI
        if (skip && PROBE_EPI == 1) { if (acc[0][0][0][0][0] == 1.2345e-30f) Y[0] = 0; return; }
        if (skip) {
            const int row0 = u.pm * 256 + wr * 64 + fr; unsigned xo = 0u;
            _Pragma("unroll") for (int bj = 0; bj < 2; ++bj) { const int col0 = u.pn * 256 + wc * 64 + bj * 32 + 8 * fq;
                _Pragma("unroll") for (int ai = 0; ai < 2; ++ai) _Pragma("unroll") for (int m = 0; m < 4; ++m) { const int row = (row0 + ai * 128 + m * 16) & (PROBE_EPI == 4 ? 0xff : 0xffff);
                    const pg8::f32x4 v0 = acc[ai][bj][m][0] * (1.0f / (SC_G8 * SC_W8)) + 0.5f, v1 = acc[ai][bj][m][1] * (1.0f / (SC_G8 * SC_W8)) + 0.25f;
                    pg8::u32x4 w; w.x = pk2(v0[0], v0[1]); w.y = pk2(v0[2], v0[3]); w.z = pk2(v1[0], v1[1]); w.w = pk2(v1[2], v1[3]);
                    if (PROBE_EPI == 3) { xo ^= w.x ^ w.y ^ w.z ^ w.w; } else
                    *(pg8::u32x4*)(Y2 + (size_t)row * D + col0) = w; } }
            if (PROBE_EPI == 3 && xo == 0x12345678u) Y2[0] = 1;
            return; }
#endif
        const int row0 = u.pm * 256 + wr * 64 + fr;
        const int e = __builtin_amdgcn_readfirstlane(ptab[u.pm]);
        const float* be = b2 + (size_t)e * D;
        f32x4 bav[2], bbv[2];
#pragma unroll
        for (int bj = 0; bj < 2; ++bj) { const int col0 = u.pn * 256 + wc * 64 + bj * 32 + 8 * fq; bav[bj] = *(const f32x4*)(be + col0); bbv[bj] = *(const f32x4*)(be + col0 + 4); }
#pragma unroll
        for (int bj = 0; bj < 2; ++bj) {
            const int col0 = u.pn * 256 + wc * 64 + bj * 32 + 8 * fq;
            const f32x4 ba = bav[bj], bb = bbv[bj];
#pragma unroll
            for (int ai = 0; ai < 2; ++ai)
#pragma unroll
                for (int m = 0; m < 4; ++m) {
                    const int row = row0 + ai * 128 + m * 16;
                    const pg8::f32x4 v0 = acc[ai][bj][m][0] * (1.0f / (SC_G8 * SC_W8)) + ba, v1 = acc[ai][bj][m][1] * (1.0f / (SC_G8 * SC_W8)) + bb;
                    pg8::u32x4 w; w.x = pk2(v0[0], v0[1]); w.y = pk2(v0[2], v0[3]); w.z = pk2(v1[0], v1[1]); w.w = pk2(v1[2], v1[3]);
#ifdef PROBE_NT
                    { const bf16* ap_ = Y + (size_t)row * D + col0; asm volatile("global_store_dwordx4 %0, %1, off " PROBE_NT "\n\ts_nop 1" :: "v"(ap_), "v"(w) : "memory"); }
#else
                    *(pg8::u32x4*)(Y + (size_t)row * D + col0) = w;
#endif
                }
        }
    }
};

template <int MAP> __device__ __forceinline__ int colmap(int c) {
    if (MAP == 1) {
        const bool rope = (c < 512) || (c >= 768 && c < 1280) || (c >= 2304 && c < 2816) || (c >= 3072 && c < 3648);
        if (rope) { const int d = c & 63; return (c & ~63) + 2 * (d & 31) + (d >> 5); }
        return c;
    }
    if (MAP == 2) { const int sgl = c >> 10, j = c & 1023; return (j >> 7) * 256 + sgl * 128 + (j & 127); }
    if (MAP == 3) return c;
    return c;
}
template <int MAP> __device__ __forceinline__ void transpose_item(const float* W, int K, int N, bf16* WT, LAS float* scr, int item, int lane, int n0_given = -1) {
    const int nblk = (N + 31) / 32, kb = (n0_given >= 0) ? item : item / nblk, nb = item % nblk, k0 = 128 * kb, n0 = (n0_given >= 0) ? n0_given : 32 * nb;
    const int col = n0 + (lane & 31);
    float v[64];
    const float* src = W + (size_t)(k0 + (lane >> 5)) * N + col;
#pragma unroll
    for (int i = 0; i < 64; ++i) v[i] = (col < N) ? src[(size_t)(2 * i) * N] : 0.f;
#pragma unroll
    for (int i = 0; i < 64; ++i) scr[(2 * i + (lane >> 5)) * 33 + (lane & 31)] = v[i];
    LDS_WAIT(); asm volatile("" ::: "memory");
    const int c = lane & 7;
#pragma unroll
    for (int j = 0; j < 4; ++j) { const int n = (lane >> 3) + 8 * j; const LAS float* s = scr + (16 * c) * 33 + n;
        if (MAP >= 2) {
            v4u o8; o8.x = pk4_fp8(s[0 * 33] * SC_W8, s[1 * 33] * SC_W8, s[2 * 33] * SC_W8, s[3 * 33] * SC_W8); o8.y = pk4_fp8(s[4 * 33] * SC_W8, s[5 * 33] * SC_W8, s[6 * 33] * SC_W8, s[7 * 33] * SC_W8);
            o8.z = pk4_fp8(s[8 * 33] * SC_W8, s[9 * 33] * SC_W8, s[10 * 33] * SC_W8, s[11 * 33] * SC_W8); o8.w = pk4_fp8(s[12 * 33] * SC_W8, s[13 * 33] * SC_W8, s[14 * 33] * SC_W8, s[15 * 33] * SC_W8);
            if (n0 + n < N) *(GAS v4u*)((GAS unsigned char*)WT + (size_t)colmap<MAP>(n0 + n) * K + k0 + 16 * c) = o8;
        } else {
        v4u o, p; o.x = pk2(s[0 * 33], s[1 * 33]); o.y = pk2(s[2 * 33], s[3 * 33]); o.z = pk2(s[4 * 33], s[5 * 33]); o.w = pk2(s[6 * 33], s[7 * 33]);
        p.x = pk2(s[8 * 33], s[9 * 33]); p.y = pk2(s[10 * 33], s[11 * 33]); p.z = pk2(s[12 * 33], s[13 * 33]); p.w = pk2(s[14 * 33], s[15 * 33]);
        if (n0 + n < N) { GAS v4u* dst = (GAS v4u*)(WT + (size_t)colmap<MAP>(n0 + n) * K + k0 + 16 * c); dst[0] = o; dst[1] = p; } } }
    LDS_WAIT(); asm volatile("" ::: "memory");
}
__device__ __forceinline__ void p0_prologue(Frame& F) {
    PH_IDS; const float* w_in = LIN(1, 0); const float* w_out = LIN(11, 0); const float* exp_w1 = LIN(16, 0); const float* exp_w2 = LIN(18, 0);
    LAS float* scr = (LAS float*)(F.lds + w * 16896);
    const int gw = bid_ * NWAVES + w, NGW = G_ * NWAVES;
    constexpr int I_IN = 8 * ((INW + 31) / 32), I_OUT = 8 * 32, I_1 = 8 * 64, I_2 = 8 * 32;
    constexpr int N_IN = DEPTH * I_IN, N_OUT = DEPTH * I_OUT, N_1 = DEPTH * NE * I_1, N_2 = DEPTH * NE * I_2;
    constexpr int CB8 = 8 * P1_F8_NT, N_IN8 = P1_F8 ? DEPTH * 8 * CB8 : 0;
    constexpr int NITEMS = N_IN + N_OUT + N_1 + N_2 + N_IN8;
    for (int it = gw; it < NITEMS; it += NGW) {
        int r = it;
        if (r < N_IN) { const int l = r / I_IN;
            if (P1_F8 && ((P1_F8_SET >> ((((r % I_IN) % ((INW + 31) / 32)) * 32) >> 8)) & 1u)) continue;
            transpose_item<1>(w_in + (size_t)l * D * INW, D, INW, WSP(bf16, WS_WIN) + (size_t)l * NP * D, scr, r % I_IN, lane); continue; } r -= N_IN;
#if P6_F8
        if (r < N_OUT) { const int l = r / I_OUT; transpose_item<3>(w_out + (size_t)l * D * D, D, D, (bf16*)(WSP(unsigned char, WS_WOUT) + (size_t)l * D * D), scr, r % I_OUT, lane); continue; } r -= N_OUT;
#else
        if (r < N_OUT) { const int l = r / I_OUT; transpose_item<0>(w_out + (size_t)l * D * D, D, D, WSP(bf16, WS_WOUT) + (size_t)l * D * D, scr, r % I_OUT, lane); continue; } r -= N_OUT;
#endif
        if (r < N_1) { const int m = r / I_1; transpose_item<2>(exp_w1 + (size_t)m * D * 2048, D, 2048, (bf16*)(WSP(unsigned char, WS_W1) + (size_t)m * 2048 * D), scr, r % I_1, lane); continue; } r -= N_1;
        if (r < N_2) { const int m = r / I_2; transpose_item<3>(exp_w2 + (size_t)m * FF * D, FF, D, (bf16*)(WSP(unsigned char, WS_W2) + (size_t)m * D * FF), scr, r % I_2, lane); continue; } r -= N_2;
        { const int l = r / (8 * CB8), q = r % (8 * CB8), kb = q / CB8, cb = q % CB8, tile = (int)((P1_F8_TM >> (4 * (cb >> 3))) & 15u);
          transpose_item<3>(w_in + (size_t)l * D * INW, D, INW, (bf16*)(WSP(unsigned char, WS_WIN8) + (size_t)l * NP * D), scr, kb, lane, tile * 256 + (cb & 7) * 32); }
    }
    const int gt = bid_ * NTHR + tid, NGT = G_ * NTHR;
    for (int i = gt; i < DEPTH * (NP - INW) * (D / 8); i += NGT) { const int l = i / ((NP - INW) * (D / 8)), rr = i % ((NP - INW) * (D / 8));
        *(GAS v4u*)(WSP(bf16, WS_WIN) + (size_t)l * NP * D + (size_t)INW * D + (size_t)rr * 8) = (v4u){0u, 0u, 0u, 0u}; }
    for (int i = gt; i < T * 32; i += NGT) { const int t = i >> 5, k = i & 31;
        const float inv = powf(10000.0f, -(float)(2 * k) / 64.0f); const float ang = (float)t * inv;
        f32x2 v; v.x = cosf(ang); v.y = sinf(ang); WSP(f32x2, WS_ROPE)[i] = v; }
    { const float* rw = LIN(14, 0);
      for (int i = gt; i < DEPTH * NE * D; i += NGT) { const int l = i / (NE * D), e = (i / D) % NE, k = i % D;
          const float wv = rw[(size_t)l * D * NE + (size_t)k * NE + e]; const unsigned hb = pk2(wv, 0.f) & 0xffffu; const float hf = __uint_as_float(hb << 16);
          bf16* dst = WSP(bf16, WS_RWB) + (size_t)l * 2 * NE * D + (size_t)e * D + k; dst[0] = (bf16)hb; dst[(size_t)NE * D] = (bf16)(pk2(wv - hf, 0.f) & 0xffffu); } }
    for (int i = gt; i < DEPTH * 2 * 4 * 64 * 64; i += NGT) { const int cc = i & 63, d = (i >> 6) & 63, n = (i >> 12) & 3, gate = (i >> 14) & 1, l = i >> 15;
        const float wv = LIN(gate ? 8 : 6, 0)[(size_t)l * 16384 + n * 4096 + cc * 64 + d]; WSP(bf16, WS_RGW)[i] = (bf16)(pk2(wv, 0.f) & 0xffffu); }
    { const f32x4* xs = (const f32x4*)LIN(0, 0); constexpr size_t NCH = (size_t)M * D / 8;
      for (size_t i0 = gt; i0 < NCH; i0 += (size_t)4 * NGT) {
          f32x4 a[4], b[4];
#pragma unroll
          for (int u = 0; u < 4; ++u) { const size_t i = i0 + (size_t)u * NGT; if (i < NCH) { a[u] = __builtin_nontemporal_load(xs + 2 * i); b[u] = __builtin_nontemporal_load(xs + 2 * i + 1); } }
#pragma unroll
          for (int u = 0; u < 4; ++u) { const size_t i = i0 + (size_t)u * NGT; if (i < NCH) { v4u o; o.x = pk2(a[u][0], a[u][1]); o.y = pk2(a[u][2], a[u][3]); o.z = pk2(b[u][0], b[u][1]); o.w = pk2(b[u][2], b[u][3]); WSP(v4u, WS_XB)[i] = o;
#if P1_F8
              v2u q8; q8.x = pk4_fp8(a[u][0] * SC_X8, a[u][1] * SC_X8, a[u][2] * SC_X8, a[u][3] * SC_X8); q8.y = pk4_fp8(b[u][0] * SC_X8, b[u][1] * SC_X8, b[u][2] * SC_X8, b[u][3] * SC_X8); WSP(v2u, WS_X8)[i] = q8;
#endif
          } } } }
}

#ifndef PROBE_DSA
#define PROBE_DSA 0
#endif
__device__ __forceinline__ unsigned short score_key16(float s) {
    const _Float16 hf = (_Float16)s; const unsigned short h = __builtin_bit_cast(unsigned short, hf);
    return (h & 0x8000u) ? (unsigned short)~h : (unsigned short)(h | 0x8000u);
}
constexpr int DQ_OFF = 12288, DQ_PITCH = 1040, DQ_W_OFF = DQ_OFF + 16 * DQ_PITCH;
struct DsaPre { v4u a0, a1, wv; };
__device__ __forceinline__ void dsa_pre_issue(Frame& F, int b, int qb, DsaPre& p) {
    PH_IDS; const bf16* PJ = WSP(const bf16, WS_PJ);
    const bf16* src = PJ + (size_t)(b * T + qb * 16 + (tid >> 5)) * NP + C_QI + (tid & 31) * 16;
    p.a0 = *(const GAS v4u*)src; p.a1 = *(const GAS v4u*)(src + 8);
    p.wv = *(const GAS v4u*)(PJ + (size_t)(b * T + qb * 16 + (tid & 15)) * NP + C_W);
}
__device__ __forceinline__ void dsa_pre_commit(Frame& F, const DsaPre& p) {
    PH_IDS; LAS unsigned char* base = F.lctl;
    *(LAS v4u*)(base + DQ_OFF + (tid >> 5) * DQ_PITCH + (tid & 31) * 32) = p.a0; *(LAS v4u*)(base + DQ_OFF + (tid >> 5) * DQ_PITCH + (tid & 31) * 32 + 16) = p.a1;
    if (tid < 16) *(LAS v4u*)(base + DQ_W_OFF + tid * 16) = p.wv;
}
__device__ __forceinline__ void dsa_unit(Frame& F, int b, int qb, bool has_next, int nb, int nqb) {
    PH_IDS; const int g = lane >> 4, li = lane & 15;
    LAS unsigned short* SCK = (LAS unsigned short*)F.lds;
    LAS unsigned* hist = (LAS unsigned*)(F.lctl + LC_HIST + w * 1024);
    const bf16* PJ = WSP(const bf16, WS_PJ);
    const int t0 = qb * 16;
    GAS unsigned long long* MK = (GAS unsigned long long*)WSP(unsigned long long, WS_MASK) + (size_t)(b * T + t0) * 64;
    if (t0 + 15 < 256) {
        for (int idx = tid; idx < 1024; idx += NTHR) { const int r = idx >> 6, l = idx & 63, n = t0 + r + 1 - l * 64;
            MK[idx] = n >= 64 ? ~0ull : (n <= 0 ? 0ull : ((1ull << n) - 1ull)); }
        if (has_next) { DsaPre p; dsa_pre_issue(F, nb, nqb, p); __syncthreads(); dsa_pre_commit(F, p); }
        return;
    }
    __syncthreads();
    {
        const int hh = lane >> 5, l31 = lane & 31;
        const int rq = 2 * (l31 >> 4) + ((l31 >> 2) & 1), rh = 4 * ((l31 >> 3) & 1) + (l31 & 3);
        bf16x8 af[4][4]; f32x2 wq[4][8];
#pragma unroll
        for (int rt = 0; rt < 4; ++rt) {
            const LAS unsigned char* ap = F.lctl + DQ_OFF + (4 * rt + rq) * DQ_PITCH + rh * 128 + 16 * hh;
#pragma unroll
            for (int ks = 0; ks < 4; ++ks) af[rt][ks] = *(const LAS bf16x8*)(ap + ks * 32);
#pragma unroll
            for (int qh = 0; qh < 2; ++qh) {
                const v4u wv = *(const LAS v4u*)(F.lctl + DQ_W_OFF + (4 * rt + 2 * qh + hh) * 16);
                wq[rt][0][qh] = bflo(wv.x); wq[rt][1][qh] = bfhi(wv.x); wq[rt][2][qh] = bflo(wv.y); wq[rt][3][qh] = bfhi(wv.y);
                wq[rt][4][qh] = bflo(wv.z); wq[rt][5][qh] = bfhi(wv.z); wq[rt][6][qh] = bflo(wv.w); wq[rt][7][qh] = bfhi(wv.w);
            }
        }
        const int nsub = (t0 + 15) / 32 + 1;
        const bf16* kp = PJ + (size_t)(b * T + l31) * NP + C_KI + 8 * hh;
#define DSA_LOAD(buf, jj) do { const int j_ = (jj) < nsub ? (jj) : 0; _Pragma("unroll") for (int ks = 0; ks < 4; ++ks) buf[ks] = *(const GAS bf16x8*)(kp + (size_t)j_ * 32 * NP + ks * 16); } while (0)
#define DSA_TILE(buf, jj) do { if ((jj) < nsub) { _Pragma("unroll") for (int rt = 0; rt < 4; ++rt) { \
            f32x16 acc; _Pragma("unroll") for (int i = 0; i < 16; ++i) acc[i] = 0.f; \
            _Pragma("unroll") for (int ks = 0; ks < 4; ++ks) acc = __builtin_amdgcn_mfma_f32_32x32x16_bf16(af[rt][ks], buf[ks], acc, 0, 0, 0); \
            f32x2 sv = {0.f, 0.f}; \
            _Pragma("unroll") for (int i = 0; i < 8; ++i) {   \
                const f32x2 rv = {__int_as_float(max(__float_as_int(acc[i]), 0)), __int_as_float(max(__float_as_int(acc[8 + i]), 0))}; \
                sv = __builtin_elementwise_fma(wq[rt][i], rv, sv); }        \
            SCK[(4 * rt + hh) * 4096 + (jj) * 32 + l31] = score_key16(sv.x + 0.0f); \
            SCK[(4 * rt + 2 + hh) * 4096 + (jj) * 32 + l31] = score_key16(sv.y + 0.0f); } } } while (0)
        bf16x8 bX[4], bY[4], bZ[4];
        for (int prep_ = 0; prep_ < (((PROBE_DSA) & 1) ? 2 : 1); ++prep_) {
        DSA_LOAD(bX, w); DSA_LOAD(bY, w + 8);
        for (int j = w; j < nsub; j += 24) {
            DSA_LOAD(bZ, j + 16); DSA_TILE(bX, j);
            DSA_LOAD(bX, j + 24); DSA_TILE(bY, j + 8);
            DSA_LOAD(bY, j + 32); DSA_TILE(bZ, j + 16);
        }
        }
#undef DSA_LOAD
#undef DSA_TILE
    }
    __syncthreads();
    DsaPre pre; if (has_next) dsa_pre_issue(F, nb, nqb, pre);
#pragma unroll 1
    for (int rr_ = 0; rr_ < ((((PROBE_DSA) >> 1) & 1) ? 4 : 2); ++rr_) {
        const int rr = rr_ & 1;
        const int r = 2 * w + rr, t = t0 + r, ns = (t >> 6) + 1;
        unsigned key[64];
        const LAS unsigned short* kr = SCK + r * 4096 + lane;
#pragma unroll
        for (int g8 = 0; g8 < 8; ++g8) {
            if (g8 * 8 < ns) {
#pragma unroll
                for (int j = 0; j < 8; ++j) { const int i = g8 * 8 + j; const unsigned k = kr[64 * i]; key[i] = (64 * i + lane <= t) ? k : 0u; }
            } else {
#pragma unroll
                for (int j = 0; j < 8; ++j) key[g8 * 8 + j] = 0u;
            }
        }
        unsigned prefix = 0u; int kneed = 256;
#pragma unroll
        for (int pass = 0; pass < 2; ++pass) {
            const int shift = 8 - 8 * pass;
            *(LAS v4u*)(hist + 4 * lane) = (v4u){0u, 0u, 0u, 0u};
#pragma unroll
            for (int g8 = 0; g8 < 8; ++g8) {
                if (g8 * 8 < ns) {
#pragma unroll
                    for (int j = 0; j < 8; ++j) { const unsigned k = key[g8 * 8 + j];
                        const bool m = (k != 0u) && (pass == 0 || (k >> 8) == (prefix >> 8));
                        if (m) atomicAdd((unsigned*)(hist + ((k >> shift) & 255u)), 1u); }
                }
            }
            const v4u c = *(const LAS v4u*)(hist + 4 * lane);
            const int s4 = (int)(c.x + c.y + c.z + c.w);
            const int pre = wave_prefix_incl(s4);
            const int tot = __builtin_amdgcn_readlane(pre, 63);
            int run = tot - pre, fb = -1, fa = 0;
            if (run < kneed && kneed <= run + (int)c.w) { fb = 4 * lane + 3; fa = run; } run += (int)c.w;
            if (fb < 0 && run < kneed && kneed <= run + (int)c.z) { fb = 4 * lane + 2; fa = run; } run += (int)c.z;
            if (fb < 0 && run < kneed && kneed <= run + (int)c.y) { fb = 4 * lane + 1; fa = run; } run += (int)c.y;
            if (fb < 0 && run < kneed && kneed <= run + (int)c.x) { fb = 4 * lane + 0; fa = run; }
            const unsigned long long bm = __builtin_amdgcn_ballot_w64(fb >= 0);
            const int src = bm ? (int)__builtin_ctzll(bm) : 0;
            const int bsel = __builtin_amdgcn_readlane(fb, src), asel = __builtin_amdgcn_readlane(fa, src);
            prefix |= ((unsigned)bsel & 255u) << shift; kneed -= asel;
        }
        const unsigned thr = prefix;
        int remaining = kneed;
        unsigned long long word = 0ull;
#pragma unroll
        for (int g8 = 0; g8 < 8; ++g8) {
            if (g8 * 8 < ns) {
#pragma unroll
                for (int j = 0; j < 8; ++j) { const int i = g8 * 8 + j;
                    const unsigned long long gm = __builtin_amdgcn_ballot_w64(key[i] > thr); unsigned long long em = __builtin_amdgcn_ballot_w64(key[i] == thr);
                    int ne = __popcll(em);
                    if (ne > remaining) { while (__popcll(em) > remaining) em &= ~(1ull << (63 - __clzll((long long)em))); ne = remaining; }
                    remaining -= ne;
                    const unsigned long long wi = gm | em;
                    word = (lane == i) ? wi : word; }
            }
        }
        MK[r * 64 + lane] = word;
    }
    if (has_next) dsa_pre_commit(F, pre);
}
__device__ __forceinline__ void ret_state_load(Frame& F, int b, int h, int c, v4u (&kv)[2], v4u (&vv)[2]) {
    PH_IDS; const bf16* PJ = WSP(const bf16, WS_PJ);
#pragma unroll
    for (int i = 0; i < 2; ++i) { const int idx = tid + NTHR * i, r = idx >> 3, cc = idx & 7;
        const size_t rb = (size_t)(b * T + c * 128 + r) * NP + h * 64 + cc * 8;
        kv[i] = *(const GAS v4u*)(PJ + rb + C_RK); vv[i] = *(const GAS v4u*)(PJ + rb + C_RV); }
}
__device__ __forceinline__ void ret_state_unit(Frame& F, int b, int h, int c, v4u (&kvp)[2], v4u (&vvp)[2], bool has_next, int nb, int nh, int nc) {
    PH_IDS;
    constexpr int TP = 136;
    LAS bf16* KT = (LAS bf16*)F.lds;
    LAS bf16* VT = KT + 64 * TP;
    const bf16* PJ = WSP(const bf16, WS_PJ);
    const float lg = log2f(1.0f - exp2f(-5.0f - (float)h));
    __syncthreads();
    {
        const v4u kv[2] = {kvp[0], kvp[1]}, vv[2] = {vvp[0], vvp[1]};
#pragma unroll
        for (int i = 0; i < 2; ++i) { const int idx = tid + NTHR * i, r = idx >> 3, cc = idx & 7;
            const float z = exp2f((float)(127 - r) * lg);
            const unsigned k01 = pk2(bflo(kv[i].x) * z, bfhi(kv[i].x) * z), k23 = pk2(bflo(kv[i].y) * z, bfhi(kv[i].y) * z), k45 = pk2(bflo(kv[i].z) * z, bfhi(kv[i].z) * z), k67 = pk2(bflo(kv[i].w) * z, bfhi(kv[i].w) * z);
            LAS bf16* kd = KT + (cc * 8) * TP + r; LAS bf16* vd = VT + (cc * 8) * TP + r;
            kd[0 * TP] = (bf16)(k01 & 0xffffu); kd[1 * TP] = (bf16)(k01 >> 16); kd[2 * TP] = (bf16)(k23 & 0xffffu); kd[3 * TP] = (bf16)(k23 >> 16);
            kd[4 * TP] = (bf16)(k45 & 0xffffu); kd[5 * TP] = (bf16)(k45 >> 16); kd[6 * TP] = (bf16)(k67 & 0xffffu); kd[7 * TP] = (bf16)(k67 >> 16);
            vd[0 * TP] = (bf16)(vv[i].x & 0xffffu); vd[1 * TP] = (bf16)(vv[i].x >> 16); vd[2 * TP] = (bf16)(vv[i].y & 0xffffu); vd[3 * TP] = (bf16)(vv[i].y >> 16);
            vd[4 * TP] = (bf16)(vv[i].z & 0xffffu); vd[5 * TP] = (bf16)(vv[i].z >> 16); vd[6 * TP] = (bf16)(vv[i].w & 0xffffu); vd[7 * TP] = (bf16)(vv[i].w >> 16); }
    }
    if (has_next) ret_state_load(F, nb, nh, nc, kvp, vvp);
    __syncthreads();
    const int et = w >> 1, dt0 = (w & 1) * 2, j = lane & 15, g = lane >> 4;
    f32x4 acc0 = {0.f, 0.f, 0.f, 0.f}, acc1 = {0.f, 0.f, 0.f, 0.f};
#pragma unroll
    for (int ks = 0; ks < 4; ++ks) {
        const bf16x8 af = *(const LAS bf16x8*)(VT + (et * 16 + j) * TP + ks * 32 + 8 * g);
        const bf16x8 b0 = *(const LAS bf16x8*)(KT + (dt0 * 16 + j) * TP + ks * 32 + 8 * g), b1 = *(const LAS bf16x8*)(KT + ((dt0 + 1) * 16 + j) * TP + ks * 32 + 8 * g);
        acc0 = mfma16(af, b0, acc0); acc1 = mfma16(af, b1, acc1);
    }
    float* dst = WSP(float, WS_ST) + ((size_t)((b * 4 + h) * 32 + c) * 64 + et * 16 + 4 * g) * 64 + dt0 * 16 + j;
#pragma unroll
    for (int r = 0; r < 4; ++r) { dst[(size_t)r * 64] = acc0[r]; dst[(size_t)r * 64 + 16] = acc1[r]; }
}
__device__ __forceinline__ void kmean_unit(Frame& F, int b, int n, int kind_sel) {
    PH_IDS;
    LAS float* part = (LAS float*)F.lds;
    LAS float* nmax = part + 16 * 256;
    const bf16* PJ = WSP(const bf16, WS_PJ);
    const int ch = tid & 31, rgp = tid >> 5;
    __syncthreads();
    {   const int kind = kind_sel;
        v4u v[16];
#pragma unroll
        for (int i = 0; i < 16; ++i) v[i] = *(const GAS v4u*)(PJ + (size_t)(b * T + n * 256 + rgp + 16 * i) * NP + (kind == 0 ? C_AK : C_DK) + ch * 8);
        float a8[8], m2 = 0.f;
#pragma unroll
        for (int k = 0; k < 8; ++k) a8[k] = 0.f;
#pragma unroll
        for (int i = 0; i < 16; ++i) {
            const float x0 = bflo(v[i].x), x1 = bfhi(v[i].x), x2 = bflo(v[i].y), x3 = bfhi(v[i].y), x4 = bflo(v[i].z), x5 = bfhi(v[i].z), x6 = bflo(v[i].w), x7 = bfhi(v[i].w);
            a8[0] += x0; a8[1] += x1; a8[2] += x2; a8[3] += x3; a8[4] += x4; a8[5] += x5; a8[6] += x6; a8[7] += x7;
            float ss = (x0 * x0 + x1 * x1) + (x2 * x2 + x3 * x3) + (x4 * x4 + x5 * x5) + (x6 * x6 + x7 * x7);
            ss += __shfl_xor(ss, 1); ss += __shfl_xor(ss, 2); ss += __shfl_xor(ss, 4);
            m2 = fmaxf(m2, ss);
        }
        if (kind == 0) {
#pragma unroll
            for (int k = 0; k < 8; ++k) part[rgp * 256 + ch * 8 + k] = a8[k];
        }
        if ((ch & 7) == 0) nmax[(kind * 16 + rgp) * 4 + (ch >> 3)] = m2;
    }
    __syncthreads();
    if (kind_sel == 0 && tid < 256) { float sum = 0.f;
#pragma unroll
        for (int r = 0; r < 16; ++r) sum += part[r * 256 + tid];
        WSP(bf16, WS_KMB)[((size_t)(b * 4 + (tid >> 6)) * 16 + n) * 64 + (tid & 63)] = (bf16)(pk2(sum * (1.0f / 256.0f), 0.f) & 0xffffu); }
    if (tid < 4) { const int kind = kind_sel, hd = tid & 3; float m2 = 0.f;
#pragma unroll
        for (int r = 0; r < 16; ++r) m2 = fmaxf(m2, nmax[(kind * 16 + r) * 4 + hd]);
        WSP(float, WS_KN2)[((size_t)(kind * NB + b) * 4 + hd) * 16 + n] = m2; }
}
struct RgOps { v4u rv[5]; };
__device__ __forceinline__ void rg_raw_load(Frame& F, int b, int k, RgOps& ops) {
    PH_IDS; const bf16* PJ = WSP(const bf16, WS_PJ); const int t0 = k * 64;
#pragma unroll
    for (int i = 0; i < 5; ++i) { const int idx = tid + NTHR * i, rr = idx >> 5, cc = idx & 31, t = t0 - 3 + rr;
        ops.rv[i] = (idx < 67 * 32 && t >= 0) ? *(const GAS v4u*)(PJ + (size_t)(b * T + t) * NP + C_CX + cc * 8) : (v4u){0u, 0u, 0u, 0u}; }
}
__device__ __forceinline__ void rg_local_unit(Frame& F, int b, int k, RgOps& ops, bool has_next, int nb, int nk) {
    PH_IDS;
    LAS float* XC = (LAS float*)F.lds;
    LAS float* AS = XC + 64 * 256;
    const bf16* PJ = WSP(const bf16, WS_PJ);
    const int c = tid & 255, th = tid >> 8;
    const int t0 = k * 64;
    const int gn = w >> 1, gh = w & 1, gj = lane & 15, gg = lane >> 4;
    bf16x8 bw[2][4][2];
    { const bf16* wt = WSP(const bf16, WS_RGW) + (size_t)F.layer * 32768 + (size_t)gn * 4096 + gj * 64 + 8 * gg;
#pragma unroll
      for (int gate = 0; gate < 2; ++gate)
#pragma unroll
          for (int dt = 0; dt < 4; ++dt)
#pragma unroll
              for (int ks = 0; ks < 2; ++ks) bw[gate][dt][ks] = *(const GAS bf16x8*)(wt + gate * 16384 + dt * 1024 + ks * 32); }
    __syncthreads();
    {
        LAS bf16* RAW = (LAS bf16*)AS;
#pragma unroll
        for (int i = 0; i < 5; ++i) { const int idx = tid + NTHR * i; if (idx < 67 * 32) *(LAS v4u*)(RAW + idx * 8) = ops.rv[i]; }
        __syncthreads();
        const float* cw_ = LIN(4, 1024);
        const float w0 = cw_[0 * 256 + c], w1 = cw_[1 * 256 + c], w2 = cw_[2 * 256 + c], w3 = cw_[3 * 256 + c], cb = LIN(5, 256)[c];
#pragma unroll 8
        for (int i = 0; i < 32; ++i) { const int tl = th + 2 * i;
            XC[tl * 256 + c] = cb + w0 * bf2f(RAW[tl * 256 + c]) + w1 * bf2f(RAW[(tl + 1) * 256 + c]) + w2 * bf2f(RAW[(tl + 2) * 256 + c]) + w3 * bf2f(RAW[(tl + 3) * 256 + c]); }
    }
    __syncthreads();
    float bt[2][4][4];
    {
        f32x4 ax[2][4], aa[2][4];
#pragma unroll
        for (int tt2 = 0; tt2 < 2; ++tt2)
#pragma unroll
            for (int dt = 0; dt < 4; ++dt) { ax[tt2][dt] = (f32x4){0.f, 0.f, 0.f, 0.f}; aa[tt2][dt] = (f32x4){0.f, 0.f, 0.f, 0.f}; }
#pragma unroll
        for (int tt2 = 0; tt2 < 2; ++tt2)
#pragma unroll
            for (int ks = 0; ks < 2; ++ks) {
                const LAS float* xp = XC + ((gh * 2 + tt2) * 16 + gj) * 256 + gn * 64 + ks * 32 + 8 * gg;
                const f32x4 x0 = *(const LAS f32x4*)xp, x1 = *(const LAS f32x4*)(xp + 4);
                v4u pa; pa.x = pk2(x0[0], x0[1]); pa.y = pk2(x0[2], x0[3]); pa.z = pk2(x1[0], x1[1]); pa.w = pk2(x1[2], x1[3]);
                const bf16x8 af = __builtin_bit_cast(bf16x8, pa);
#pragma unroll
                for (int dt = 0; dt < 4; ++dt) { ax[tt2][dt] = mfma16(af, bw[0][dt][ks], ax[tt2][dt]); aa[tt2][dt] = mfma16(af, bw[1][dt][ks], aa[tt2][dt]); }
            }
#pragma unroll
        for (int dt = 0; dt < 4; ++dt) {
            const int cch = gn * 64 + dt * 16 + gj;
            const float bx = LIN(7, 256)[cch], ba = LIN(9, 256)[cch], lam = LIN(10, 256)[cch];
            const float sp = 0.6931471805599453f * __builtin_amdgcn_logf(1.0f + __builtin_amdgcn_exp2f(-1.4426950408889634f * lam));
#pragma unroll
            for (int tt2 = 0; tt2 < 2; ++tt2)
#pragma unroll
                for (int r = 0; r < 4; ++r) {
                    const int tl = (gh * 2 + tt2) * 16 + 4 * gg + r;
                    const float gx = sigmoidf_(ax[tt2][dt][r] + bx), ga = sigmoidf_(aa[tt2][dt][r] + ba);
                    const float la = -8.0f * ga * sp; const float a = __builtin_amdgcn_exp2f(la * 1.4426950408889634f);
                    bt[tt2][dt][r] = __builtin_amdgcn_sqrtf(fmaxf(fmaf(-a, a, 1.0f), 0.0f)) * (gx * XC[tl * 256 + cch]);
                    AS[tl * 256 + cch] = a;
                }
        }
    }
    __syncthreads();
#pragma unroll
    for (int dt = 0; dt < 4; ++dt)
#pragma unroll
        for (int tt2 = 0; tt2 < 2; ++tt2)
#pragma unroll
            for (int r = 0; r < 4; ++r) XC[((gh * 2 + tt2) * 16 + 4 * gg + r) * 256 + gn * 64 + dt * 16 + gj] = bt[tt2][dt][r];
    __syncthreads();
    if (has_next) rg_raw_load(F, nb, nk, ops);
    if (tid < 256) {
        float h = 0.f, P = 1.f;
        unsigned* hp = WSP(unsigned, WS_HLOC) + (size_t)(b * T + t0) * 256 + c;
        for (int tl = 0; tl < 64; ++tl) { const float a = AS[tl * 256 + c], bb = XC[tl * 256 + c]; h = fmaf(a, h, bb); P *= a; hp[(size_t)tl * 256] = pk2(h, P); }
        WSP(float, WS_RGS)[(size_t)(b * 64 + k) * 256 + c] = P;
        WSP(float, WS_RGS)[(size_t)131072 + (size_t)(b * 64 + k) * 256 + c] = h;
    }
}

__device__ __forceinline__ void ret_prefix(Frame& F) {
    PH_IDS; const int gt = bid_ * NTHR + tid, NGT = G_ * NTHR;
    for (int i = gt; i < 32 * 4096; i += NGT) {
        const int bh = i >> 12, idx = i & 4095, h = bh & 3;
        const float gc = exp2f(128.0f * log2f(1.0f - exp2f(-5.0f - (float)h)));
        const float* st = WSP(const float, WS_ST) + (size_t)bh * 32 * 4096 + idx; bf16* rt = WSP(bf16, WS_RT) + (size_t)bh * 32 * 4096 + idx;
        float R = 0.f;
        for (int c = 0; c < 32; ++c) { rt[(size_t)c * 4096] = (bf16)(pk2(R, 0.f) & 0xffffu); R = st[(size_t)c * 4096] + gc * R; }
    }
}
__device__ __forceinline__ void rg_carry(Frame& F) {
    PH_IDS; const int gt = bid_ * NTHR + tid, NGT = G_ * NTHR;
    float* S = WSP(float, WS_RGS);
    for (int i = gt; i < NB * 256; i += NGT) {
        const int b = i >> 8, c = i & 255;
        float h = 0.f;
        for (int k = 0; k < 64; ++k) { const size_t o = (size_t)(b * 64 + k) * 256 + c; S[262144 + o] = h; h = fmaf(S[o], h, S[131072 + o]); }
    }
}

__device__ __forceinline__ bf16x8 pack8(const f32x4& a, const f32x4& b) {
    v4u w; w.x = pk2(a[0], a[1]); w.y = pk2(a[2], a[3]); w.z = pk2(b[0], b[1]); w.w = pk2(b[2], b[3]);
    return __builtin_bit_cast(bf16x8, w);
}
template <int MODE>
__device__ __forceinline__ void attn_unit(Frame& F, int b, int h, int qt) {
    PH_IDS; const int g = lane >> 4, li = lane & 15;
    LAS bf16* LB = (LAS bf16*)F.lds;
    LAS unsigned* wgsel = (LAS unsigned*)(F.lds + 2 * 9216 * 2);
    LAS v2u* plut = (LAS v2u*)(F.lds + 2 * 9216 * 2 + 64);
    const bf16* PJ = WSP(const bf16, WS_PJ);
    constexpr int qoff = MODE == 0 ? C_DQ : (MODE == 1 ? C_AQ : C_RQ), koff = MODE == 0 ? C_DK : (MODE == 1 ? C_AK : C_RK), voff = MODE == 0 ? C_DV : (MODE == 1 ? C_AV : C_RV);
    constexpr int ocol = MODE == 0 ? 768 : (MODE == 1 ? 0 : 256);
    const int q0 = qt * 256 + w * 32, wqmax = q0 + 31;
    bf16x8 qf[2][2];
#pragma unroll
    for (int qq = 0; qq < 2; ++qq)
#pragma unroll
        for (int ks = 0; ks < 2; ++ks) qf[qq][ks] = *(const GAS bf16x8*)(PJ + (size_t)(b * T + q0 + qq * 16 + li) * NP + qoff + h * 64 + ks * 32 + g * 8);
    const int kt_lo = (MODE == 2) ? 4 * qt : 0, kt_hi = 4 * qt + 3;
    const int sr = tid >> 3, sc = tid & 7;
    v4u kreg, vreg;
    { const size_t rb = (size_t)(b * T + kt_lo * 64 + sr) * NP + h * 64 + sc * 8; kreg = *(const GAS v4u*)(PJ + rb + koff); vreg = *(const GAS v4u*)(PJ + rb + voff); }
    const GAS unsigned long long* mkp = (const GAS unsigned long long*)WSP(const unsigned long long, WS_MASK) + (size_t)(b * T + q0 + li) * 64;
    unsigned long long mnx0 = ~0ull, mnx1 = ~0ull;
    if (MODE == 0) { mnx0 = mkp[kt_lo]; mnx1 = mkp[16 * 64 + kt_lo]; }
    f32x4 O[2][4], OL[2]; unsigned sel[2]; f32x4 negb[2];
#pragma unroll
    for (int qq = 0; qq < 2; ++qq) { sel[qq] = 0u; OL[qq] = (f32x4){0.f, 0.f, 0.f, 0.f}; negb[qq] = (f32x4){0.f, 0.f, 0.f, 0.f};
#pragma unroll
        for (int dt = 0; dt < 4; ++dt) O[qq][dt] = (f32x4){0.f, 0.f, 0.f, 0.f}; }
    unsigned wsel = 0xffffffffu;
    const float lg = (MODE == 2) ? log2f(1.0f - exp2f(-5.0f - (float)h)) : 0.f;
    float kfac[2][2][4];
#pragma unroll
    for (int sub = 0; sub < 2; ++sub)
#pragma unroll
        for (int hf = 0; hf < 2; ++hf)
#pragma unroll
            for (int r = 0; r < 4; ++r) kfac[sub][hf][r] = (MODE == 2) ? __builtin_amdgcn_exp2f(-(float)(sub * 32 + hf * 16 + g * 4 + r) * lg) : 0.f;
    if (MODE != 2) {
        const float* kn = WSP(const float, WS_KN2) + ((size_t)((MODE == 0 ? NB : 0) + b) * 4 + h) * 16;
        float km2 = (li <= qt) ? kn[li] : 0.f;
#pragma unroll
        for (int o = 1; o < 16; o <<= 1) km2 = fmaxf(km2, __shfl_xor(km2, o));
#pragma unroll
        for (int qq = 0; qq < 2; ++qq) {
            float q2 = 0.f;
#pragma unroll
            for (int ks = 0; ks < 2; ++ks) { const v4u qw = __builtin_bit_cast(v4u, qf[qq][ks]);
                q2 += (bflo(qw.x) * bflo(qw.x) + bfhi(qw.x) * bfhi(qw.x)) + (bflo(qw.y) * bflo(qw.y) + bfhi(qw.y) * bfhi(qw.y)) + (bflo(qw.z) * bflo(qw.z) + bfhi(qw.z) * bfhi(qw.z)) + (bflo(qw.w) * bflo(qw.w) + bfhi(qw.w) * bfhi(qw.w)); }
            q2 += __shfl_xor(q2, 16); q2 += __shfl_xor(q2, 32);
            const float bq = fminf(sqrtf(q2 * km2) * 1.001f + 1e-3f, 60.0f);
            negb[qq] = (f32x4){-bq, -bq, -bq, -bq};
        }
    }
    __syncthreads();
    if (tid < 16) { v2u e; e.x = ((tid & 1) ? 0xffffu : 0u) | ((tid & 2) ? 0xffff0000u : 0u); e.y = ((tid & 4) ? 0xffffu : 0u) | ((tid & 8) ? 0xffff0000u : 0u); plut[tid] = e; }
    if (MODE == 1) {
        const int own = qt;
        if (tid == 0) *wgsel = 0u;
        const bf16* km = WSP(const bf16, WS_KMB) + ((size_t)(b * 4 + h) * 16 + li) * 64;
        const bf16x8 km0 = *(const GAS bf16x8*)(km + g * 8), km1 = *(const GAS bf16x8*)(km + 32 + g * 8);
#pragma unroll
        for (int qq = 0; qq < 2; ++qq) {
            f32x4 gt4 = {0.f, 0.f, 0.f, 0.f};
            gt4 = mfma16(km0, qf[qq][0], gt4); gt4 = mfma16(km1, qf[qq][1], gt4);
            unsigned sq = 0u;
#pragma unroll
            for (int round = 0; round < 3; ++round) {
                float bv = -INFINITY; int bn = 99;
#pragma unroll
                for (int r = 0; r < 4; ++r) { const int n = g * 4 + r; if (n < own && !((sq >> n) & 1u) && gt4[r] > bv) { bv = gt4[r]; bn = n; } }
#pragma unroll
                for (int o = 16; o <= 32; o <<= 1) { const float ov = __shfl_xor(bv, o); const int on = __shfl_xor(bn, o); if (ov > bv || (ov == bv && on < bn)) { bv = ov; bn = on; } }
                if (bn < 16) sq |= 1u << bn;
            }
            sel[qq] = sq | (1u << own);
        }
        __syncthreads();
        if (g == 0) atomicOr((unsigned*)wgsel, sel[0] | sel[1]);
        __syncthreads();
        wsel = *wgsel;
    }
    int kt = kt_lo;
    if (MODE == 1) { while (kt <= kt_hi && !((wsel >> (kt >> 2)) & 1u)) kt = (kt | 3) + 1; }
    if (MODE == 1 && kt != kt_lo && kt <= kt_hi) {
        const size_t rb = (size_t)(b * T + kt * 64 + sr) * NP + h * 64 + sc * 8; kreg = *(const GAS v4u*)(PJ + rb + koff); vreg = *(const GAS v4u*)(PJ + rb + voff); }
    const v4u onesw = (li == 0) ? (v4u){0x3f803f80u, 0x3f803f80u, 0x3f803f80u, 0x3f803f80u} : (v4u){0u, 0u, 0u, 0u};
    const bf16x8 onesf = __builtin_bit_cast(bf16x8, onesw);
    const f32x4 ninf4 = {-INFINITY, -INFINITY, -INFINITY, -INFINITY};
    int cur = 0;
    while (kt <= kt_hi) {
        LAS bf16* Ks = LB + cur * 9216; LAS bf16* Vt = Ks + 4608;
        *(LAS v4u*)(Ks + sr * 72 + sc * 8) = kreg;
        { LAS bf16* vd = Vt + (sc * 8) * 72 + (sr ^ (sc << 3));
          vd[0 * 72] = (bf16)(vreg.x & 0xffffu); vd[1 * 72] = (bf16)(vreg.x >> 16); vd[2 * 72] = (bf16)(vreg.y & 0xffffu); vd[3 * 72] = (bf16)(vreg.y >> 16);
          vd[4 * 72] = (bf16)(vreg.z & 0xffffu); vd[5 * 72] = (bf16)(vreg.z >> 16); vd[6 * 72] = (bf16)(vreg.w & 0xffffu); vd[7 * 72] = (bf16)(vreg.w >> 16); }
        __syncthreads();
        int ktn = kt + 1;
        if (MODE == 1) { while (ktn <= kt_hi && !((wsel >> (ktn >> 2)) & 1u)) ktn = (ktn | 3) + 1; }
        if (ktn <= kt_hi) { const size_t rb = (size_t)(b * T + ktn * 64 + sr) * NP + h * 64 + sc * 8; kreg = *(const GAS v4u*)(PJ + rb + koff); vreg = *(const GAS v4u*)(PJ + rb + voff); }
        const unsigned long long mcu0 = mnx0, mcu1 = mnx1;
        if (MODE == 0 && ktn <= kt_hi) { mnx0 = mkp[ktn]; mnx1 = mkp[16 * 64 + ktn]; }
        const bool diag = (kt * 64 + 63 > q0);
        const bool masked = (MODE == 0) || (MODE == 2) || diag;
        unsigned long long mwq[2]; f32x4 cin[2];
#pragma unroll
        for (int qq = 0; qq < 2; ++qq) {
            const int tqq = q0 + qq * 16 + li, d = tqq - kt * 64;
            unsigned long long cm = d >= 63 ? ~0ull : (d < 0 ? 0ull : ((2ull << d) - 1ull));
            if (MODE == 0) cm &= (qq == 0 ? mcu0 : mcu1);
            mwq[qq] = cm;
            cin[qq] = negb[qq];
            if (MODE == 1) cin[qq] = ((sel[qq] >> (kt >> 2)) & 1u) ? negb[qq] : ninf4;
        }
#pragma unroll
        for (int sub = 0; sub < 2; ++sub) {
            if (kt * 64 + sub * 32 > wqmax) continue;
            bf16x8 k0[2], k1[2];
#pragma unroll
            for (int ks = 0; ks < 2; ++ks) { k0[ks] = *(const LAS bf16x8*)(Ks + (sub * 32 + li) * 72 + ks * 32 + g * 8); k1[ks] = *(const LAS bf16x8*)(Ks + (sub * 32 + 16 + li) * 72 + ks * 32 + g * 8); }
            v2u vfa[4], vfb[4];
#pragma unroll
            for (int dt = 0; dt < 4; ++dt) { const int dim = dt * 16 + li, swz = ((dim >> 3) & 7) << 3; const LAS bf16* vrow = Vt + dim * 72;
                vfa[dt] = *(const LAS v2u*)(vrow + ((sub * 32 + g * 4) ^ swz)); vfb[dt] = *(const LAS v2u*)(vrow + ((sub * 32 + 16 + g * 4) ^ swz)); }
            __builtin_amdgcn_sched_barrier(0);
            bf16x8 pb[2];
            f32x4 sq0[2], sq1[2];
#pragma unroll
            for (int qq = 0; qq < 2; ++qq) { if (MODE == 2) { sq0[qq] = (f32x4){0.f, 0.f, 0.f, 0.f}; sq1[qq] = sq0[qq]; } else { sq0[qq] = cin[qq]; sq1[qq] = cin[qq]; } }
#pragma unroll
            for (int ks = 0; ks < 2; ++ks)
#pragma unroll
                for (int qq = 0; qq < 2; ++qq) { sq0[qq] = mfma16(k0[ks], qf[qq][ks], sq0[qq]); sq1[qq] = mfma16(k1[ks], qf[qq][ks], sq1[qq]); }
#pragma unroll
            for (int qq = 0; qq < 2; ++qq) {
                const f32x4 s0 = sq0[qq], s1 = sq1[qq];
                const unsigned mwd = (unsigned)(mwq[qq] >> (sub * 32));
                const unsigned nib0 = (mwd >> (g * 4)) & 15u, nib1 = (mwd >> (16 + g * 4)) & 15u;
                if (MODE == 2) {
                    f32x4 p0, p1;
                    const float qfac = __builtin_amdgcn_exp2f((float)(q0 + qq * 16 + li - kt * 64) * lg);
#pragma unroll
                    for (int r = 0; r < 4; ++r) {
                        p0[r] = ((nib0 >> r) & 1u) ? s0[r] * (qfac * kfac[sub][0][r]) : 0.f;
                        p1[r] = ((nib1 >> r) & 1u) ? s1[r] * (qfac * kfac[sub][1][r]) : 0.f;
                    }
                    pb[qq] = pack8(p0, p1);
                } else {
                    f32x4 p0, p1;
#pragma unroll
                    for (int r = 0; r < 4; ++r) { p0[r] = __builtin_amdgcn_exp2f(s0[r]); p1[r] = __builtin_amdgcn_exp2f(s1[r]); }
                    v4u pw = __builtin_bit_cast(v4u, pack8(p0, p1));
                    if (masked) { const v2u ma = plut[nib0], mb = plut[nib1]; pw.x &= ma.x; pw.y &= ma.y; pw.z &= mb.x; pw.w &= mb.y; }
                    pb[qq] = __builtin_bit_cast(bf16x8, pw);
                }
            }
#pragma unroll
            for (int dt = 0; dt < 4; ++dt) {
                const v2u va = vfa[dt], vb = vfb[dt];
                v4u vw; vw.x = va.x; vw.y = va.y; vw.z = vb.x; vw.w = vb.y;
                const bf16x8 vf = __builtin_bit_cast(bf16x8, vw);
                O[0][dt] = mfma16(vf, pb[0], O[0][dt]); O[1][dt] = mfma16(vf, pb[1], O[1][dt]);
            }
            if (MODE != 2) { OL[0] = mfma16(onesf, pb[0], OL[0]); OL[1] = mfma16(onesf, pb[1], OL[1]); }
        }
        kt = ktn; cur ^= 1;
    }
    bf16* MX = WSP(bf16, WS_MIX);
#pragma unroll
    for (int qq = 0; qq < 2; ++qq) {
        const int tqq = q0 + qq * 16 + li; const size_t qrow = (size_t)(b * T + tqq);
        if (MODE != 2) {
            const float lt = __shfl(OL[qq][0], li);
            const float inv = __builtin_amdgcn_rcpf(lt);
#pragma unroll
            for (int dt = 0; dt < 4; ++dt) {
#if P6_F8
                const float i8 = inv * SC_M8; *(GAS unsigned*)((GAS unsigned char*)MX + qrow * D + ocol + h * 64 + dt * 16 + g * 4) = pk4_fp8(O[qq][dt][0] * i8, O[qq][dt][1] * i8, O[qq][dt][2] * i8, O[qq][dt][3] * i8);
#else
                v2u o; o.x = pk2(O[qq][dt][0] * inv, O[qq][dt][1] * inv); o.y = pk2(O[qq][dt][2] * inv, O[qq][dt][3] * inv);
                *(GAS v2u*)(MX + qrow * D + ocol + h * 64 + dt * 16 + g * 4) = o;
#endif
            }
        } else {
            const bf16* rt = WSP(const bf16, WS_RT) + (size_t)((b * 4 + h) * 32 + 2 * qt) * 4096;
            const float xi = exp2f((float)((tqq & 255) + 1) * lg);
#pragma unroll
            for (int dt = 0; dt < 4; ++dt) {
                f32x4 cr = {0.f, 0.f, 0.f, 0.f};
                cr = mfma16(*(const GAS bf16x8*)(rt + (dt * 16 + li) * 64 + g * 8), qf[qq][0], cr); cr = mfma16(*(const GAS bf16x8*)(rt + (dt * 16 + li) * 64 + 32 + g * 8), qf[qq][1], cr);
                O[qq][dt] = O[qq][dt] + cr * xi;
            }
            float s = 0.f;
#pragma unroll
            for (int dt = 0; dt < 4; ++dt) s += (O[qq][dt][0] + O[qq][dt][1]) + (O[qq][dt][2] + O[qq][dt][3]);
            s += __shfl_xor(s, 16); s += __shfl_xor(s, 32);
            const float mu = s * (1.0f / 64.0f);
            float q = 0.f;
#pragma unroll
            for (int dt = 0; dt < 4; ++dt) { const f32x4 dd = O[qq][dt] - mu; q += (dd[0] * dd[0] + dd[1] * dd[1]) + (dd[2] * dd[2] + dd[3] * dd[3]); }
            q += __shfl_xor(q, 16); q += __shfl_xor(q, 32);
            const float rstd = 1.0f / sqrtf(q * (1.0f / 64.0f) + LN_EPS);
#pragma unroll
            for (int dt = 0; dt < 4; ++dt) {
                const int e0 = h * 64 + dt * 16 + g * 4;
                const f32x4 gg = *(const f32x4*)(LIN(2, 256) + e0), gb = *(const f32x4*)(LIN(3, 256) + e0);
                const v2u rg = *(const GAS v2u*)(PJ + qrow * NP + C_RG + e0);
                const float r0 = bflo(rg.x), r1 = bfhi(rg.x), r2 = bflo(rg.y), r3 = bfhi(rg.y);
                const float y0 = ((O[qq][dt][0] - mu) * rstd * gg[0] + gb[0]) * (r0 * sigmoidf_(r0)), y1 = ((O[qq][dt][1] - mu) * rstd * gg[1] + gb[1]) * (r1 * sigmoidf_(r1));
                const float y2 = ((O[qq][dt][2] - mu) * rstd * gg[2] + gb[2]) * (r2 * sigmoidf_(r2)), y3 = ((O[qq][dt][3] - mu) * rstd * gg[3] + gb[3]) * (r3 * sigmoidf_(r3));
#if P6_F8
                *(GAS unsigned*)((GAS unsigned char*)MX + qrow * D + ocol + e0) = pk4_fp8(y0 * SC_M8, y1 * SC_M8, y2 * SC_M8, y3 * SC_M8);
#else
                v2u o; o.x = pk2(y0, y1); o.y = pk2(y2, y3);
                *(GAS v2u*)(MX + qrow * D + ocol + e0) = o;
#endif
            }
        }
    }
}
__device__ __forceinline__ void rg_final_unit(Frame& F, int b, int k) {
    PH_IDS;
    const bf16* PJ = WSP(const bf16, WS_PJ); bf16* MX = WSP(bf16, WS_MIX);
    const int c4 = (tid & 63) * 4, tr = tid >> 6;
    const f32x4 hin = *(const f32x4*)(WSP(const float, WS_RGS) + 262144 + (size_t)(b * 64 + k) * 256 + c4);
    for (int i = 0; i < 8; ++i) {
        const size_t row = (size_t)(b * T + k * 64 + tr + 8 * i);
        const v4u hpw = __builtin_nontemporal_load((const GAS v4u*)(WSP(const unsigned, WS_HLOC) + row * 256 + c4));
        const f32x4 hl = {bflo(hpw.x), bflo(hpw.y), bflo(hpw.z), bflo(hpw.w)}, pc = {bfhi(hpw.x), bfhi(hpw.y), bfhi(hpw.z), bfhi(hpw.w)};
        const v2u gv = *(const GAS v2u*)(PJ + row * NP + C_CG + c4);
        const float gx[4] = {bflo(gv.x), bfhi(gv.x), bflo(gv.y), bfhi(gv.y)};
        float o[4];
#pragma unroll
        for (int j = 0; j < 4; ++j) { const float hh = fmaf(pc[j], hin[j], hl[j]); const float x = gx[j];
            const float ge = x * sigmoidf_(1.5957691216057308f * (x + 0.044715f * x * x * x)); o[j] = hh * ge; }
#if P6_F8
        *(GAS unsigned*)((GAS unsigned char*)MX + row * D + 512 + c4) = pk4_fp8(o[0] * SC_M8, o[1] * SC_M8, o[2] * SC_M8, o[3] * SC_M8);
#else
        v2u ov; ov.x = pk2(o[0], o[1]); ov.y = pk2(o[2], o[3]);
        *(GAS v2u*)(MX + row * D + 512 + c4) = ov;
#endif
    }
}

__device__ __forceinline__ int moe_tables(Frame& F, const bool need_ptab = true) {
    PH_IDS; LAS int* off = (LAS int*)(F.lctl + LC_OFF); LAS int* ptab = (LAS int*)(F.lctl + LC_PTAB);
    __syncthreads();
    if (tid < 64) {
        LAS int* cn = (LAS int*)(F.lctl + LC_CNT);
        int c = 0;
        if (lane < NE) c = (int)__hip_atomic_load(F.ctl + CW_CNT + (F.layer * NE + lane) * 64, RLX_AGENT);
        const int pc = (lane < NE) ? ((c + 255) & ~255) : 0;
        const int incl = wave_prefix_incl(pc);
        if (lane < NE) { off[lane] = incl - pc; cn[lane] = c; }
        if (lane == NE - 1) off[NE] = incl;
    }
    __syncthreads();
    if (!need_ptab) return off[NE] >> 8;
    for (int p = tid; p < MAXPANELS; p += NTHR) { int e = 0;
        for (int k = 1; k < NE; ++k) e += (p * 256 >= off[k]) ? 1 : 0;
        ptab[p] = e; }
    __syncthreads();
    return off[NE] >> 8;
}
__device__ __forceinline__ void router_phase(Frame& F, const bool dry = false) {
    PH_IDS; const int g_ph = lane >> 4, li_ph = lane & 15;
    LAS float* LG = (LAS float*)(F.lds + LDS_LG_OFF) + w * 512;
    LAS int* wcnt = (LAS int*)(F.lctl + LC_WCNT); LAS int* wbase = wcnt + 32;
    LAS int* rec = (LAS int*)(F.lctl + LC_REC);
    const bf16* Y1 = WSP(const bf16, WS_Y1); bf16* X1B = dry ? WSP(bf16, WS_XP) : WSP(bf16, WS_X1B);
    int* TOKO = dry ? (int*)(wsl + WS_XP + 64 * MiB) : WSP(int, WS_TOK); const int cofs = dry ? 2 * NE * 64 : 0;
    int* RT2 = dry ? (int*)(wsl + WS_XP + 80 * MiB) : WSP(int, WS_ROWTOK);
    const float* gamp = LIN(12, 1024); const float* betp = LIN(13, 1024); const float* rbp = LIN(15, 32);
    const bf16* rwb = WSP(const bf16, WS_RWB) + (size_t)F.layer * 2 * NE * D;
    __syncthreads();
    LAS unsigned char* WL = F.lds;
    { const GAS v4u* src = (const GAS v4u*)rwb; v4u tv[16];
#pragma unroll
      for (int i = 0; i < 16; ++i) tv[i] = src[tid + NTHR * i];
#pragma unroll
      for (int i = 0; i < 16; ++i) { const int c = tid + NTHR * i, row = c >> 7, ch = c & 127; *(LAS v4u*)(WL + row * 2048 + ((ch ^ ((row >> 1) & 7)) << 4)) = tv[i]; } }
    __syncthreads();
    for (int rg = bid_; rg < M / 128; rg += G_) {
        if (tid < 32) wcnt[tid] = 0;
        __syncthreads();
        const size_t r0 = (size_t)rg * 128 + w * 16;
#ifdef PROBE_RDELAY
        if (w >= 4) { for (int q_ = 0; q_ < PROBE_RDELAY; ++q_) __builtin_amdgcn_s_sleep(127); }
#endif
        int li = li_ph, g = g_ph; asm volatile("" : "+v"(li), "+v"(g));
        v4u xr[32];
        { const bf16* xrow = Y1 + (r0 + li) * D + g * 8;
#pragma unroll
          for (int ks = 0; ks < 32; ++ks) xr[ks] = *(const GAS v4u*)(xrow + ks * 32); }
        float s = 0.f;
#pragma unroll
        for (int ks = 0; ks < 32; ++ks) s += ((bflo(xr[ks].x) + bfhi(xr[ks].x)) + (bflo(xr[ks].y) + bfhi(xr[ks].y))) + ((bflo(xr[ks].z) + bfhi(xr[ks].z)) + (bflo(xr[ks].w) + bfhi(xr[ks].w)));
        s += __shfl_xor(s, 16); s += __shfl_xor(s, 32);
        const float mean = s * (1.0f / D);
#define XR_LAUNDER() _Pragma("unroll") for (int ks = 0; ks < 32; ++ks) asm volatile("" : "+v"(xr[ks]))
        XR_LAUNDER();
        float s2 = 0.f;
#pragma unroll
        for (int ks = 0; ks < 32; ++ks) { const float d0 = bflo(xr[ks].x) - mean, d1 = bfhi(xr[ks].x) - mean, d2 = bflo(xr[ks].y) - mean, d3 = bfhi(xr[ks].y) - mean, d4 = bflo(xr[ks].z) - mean, d5 = bfhi(xr[ks].z) - mean, d6 = bflo(xr[ks].w) - mean, d7 = bfhi(xr[ks].w) - mean;
            s2 += ((d0 * d0 + d1 * d1) + (d2 * d2 + d3 * d3)) + ((d4 * d4 + d5 * d5) + (d6 * d6 + d7 * d7)); }
        s2 += __shfl_xor(s2, 16); s2 += __shfl_xor(s2, 32);
        const float rstd = 1.0f / sqrtf(s2 * (1.0f / D) + LN_EPS);
        if (g == 0) { f32x2 st_; st_.x = mean; st_.y = rstd; (dry ? (f32x2*)(wsl + WS_XP + 112 * MiB) : WSP(f32x2, WS_LNS))[r0 + li] = st_; }
        XR_LAUNDER();
#undef XR_LAUNDER
        f32x4 acc0 = {0.f, 0.f, 0.f, 0.f}, acc1 = {0.f, 0.f, 0.f, 0.f};
        bf16* xbrow = X1B + (r0 + li) * D + g * 8; unsigned char* xqrow = (dry ? (unsigned char*)(wsl + WS_XP + 96 * MiB) : WSP(unsigned char, WS_X1Q)) + (r0 + li) * D + g * 8;
        const bf16* wrow = rwb + (size_t)li * D + g * 8;
#pragma unroll
        for (int ks = 0; ks < 32; ++ks) {
            const f32x4 xa = {bflo(xr[ks].x), bfhi(xr[ks].x), bflo(xr[ks].y), bfhi(xr[ks].y)}, xb4 = {bflo(xr[ks].z), bfhi(xr[ks].z), bflo(xr[ks].w), bfhi(xr[ks].w)};
            const f32x4 ga = *(const f32x4*)(gamp + ks * 32 + g * 8), gb4 = *(const f32x4*)(gamp + ks * 32 + g * 8 + 4);
            const f32x4 ba = *(const f32x4*)(betp + ks * 32 + g * 8), bb4 = *(const f32x4*)(betp + ks * 32 + g * 8 + 4);
            const LAS unsigned char* wp = WL + li * 2048 + (((ks * 4 + g) ^ ((li >> 1) & 7)) << 4);
            const bf16x8 wh0 = *(const LAS bf16x8*)wp, wh1 = *(const LAS bf16x8*)(wp + 16 * 2048);
            const bf16x8 wl0 = *(const LAS bf16x8*)(wp + 32 * 2048), wl1 = *(const LAS bf16x8*)(wp + 48 * 2048);
            const f32x4 na = (xa - mean) * rstd * ga + ba, nb = (xb4 - mean) * rstd * gb4 + bb4;
            v4u hw; hw.x = pk2(na[0], na[1]); hw.y = pk2(na[2], na[3]); hw.z = pk2(nb[0], nb[1]); hw.w = pk2(nb[2], nb[3]);
            { v2u q; q.x = pk4_fp8(na[0] * SC_X8, na[1] * SC_X8, na[2] * SC_X8, na[3] * SC_X8); q.y = pk4_fp8(nb[0] * SC_X8, nb[1] * SC_X8, nb[2] * SC_X8, nb[3] * SC_X8); *(GAS v2u*)(xqrow + ks * 32) = q; }
            v4u lw; lw.x = pk2(na[0] - bflo(hw.x), na[1] - bfhi(hw.x)); lw.y = pk2(na[2] - bflo(hw.y), na[3] - bfhi(hw.y));
                    lw.z = pk2(nb[0] - bflo(hw.z), nb[1] - bfhi(hw.z)); lw.w = pk2(nb[2] - bflo(hw.w), nb[3] - bfhi(hw.w));
            const bf16x8 ah = __builtin_bit_cast(bf16x8, hw), al = __builtin_bit_cast(bf16x8, lw);
            acc0 = mfma16(ah, wh0, acc0); acc1 = mfma16(ah, wh1, acc1);
            acc0 = mfma16(ah, wl0, acc0); acc1 = mfma16(ah, wl1, acc1);
            acc0 = mfma16(al, wh0, acc0); acc1 = mfma16(al, wh1, acc1);
            if (ks & 1) __builtin_amdgcn_sched_barrier(0);
        }
        {
            const float b0 = rbp[li], b1 = rbp[16 + li];
#pragma unroll
            for (int r = 0; r < 4; ++r) { LG[(g * 4 + r) * 32 + li] = acc0[r] + b0; LG[(g * 4 + r) * 32 + 16 + li] = acc1[r] + b1; }
        }
        LDS_WAIT(); asm volatile("" ::: "memory");
        if (lane < 16) {
            float lg[32];
#pragma unroll
            for (int e4 = 0; e4 < 8; ++e4) { const f32x4 t = *(const LAS f32x4*)(LG + lane * 32 + e4 * 4); lg[e4 * 4] = t[0]; lg[e4 * 4 + 1] = t[1]; lg[e4 * 4 + 2] = t[2]; lg[e4 * 4 + 3] = t[3]; }
            int te[4]; float tv[4]; unsigned used = 0u;
#pragma unroll
            for (int k = 0; k < 4; ++k) { float bv = -INFINITY; int be = 0;
#pragma unroll
                for (int e = 0; e < 32; ++e) { const bool ok = !((used >> e) & 1u) && lg[e] > bv; bv = ok ? lg[e] : bv; be = ok ? e : be; }
                te[k] = be; tv[k] = bv; used |= 1u << be; }
            const float e1 = __expf(tv[1] - tv[0]), e2 = __expf(tv[2] - tv[0]), e3 = __expf(tv[3] - tv[0]);
            const float inv = 1.0f / (1.0f + e1 + e2 + e3);
            const float gk[4] = {inv, e1 * inv, e2 * inv, e3 * inv};
            const int rl = w * 16 + lane;
#pragma unroll
            for (int k = 0; k < 4; ++k) { const int lr = atomicAdd((int*)&wcnt[te[k]], 1); rec[(rl * 4 + k) * 3 + 0] = te[k]; rec[(rl * 4 + k) * 3 + 1] = lr; rec[(rl * 4 + k) * 3 + 2] = __float_as_int(gk[k]); }
        }
        __syncthreads();
        if (tid < 32) wbase[tid] = (int)__hip_atomic_fetch_add(F.ctl + CW_CNT + cofs + (F.layer * NE + tid) * 64, (unsigned)wcnt[tid], RLX_AGENT);
        __syncthreads();
        {
            const int rl = tid >> 2, k = tid & 3; const size_t o = ((size_t)rg * 128 + rl) * 4 + k;
            const int e = rec[(rl * 4 + k) * 3 + 0];
            const int rk = wbase[e] + rec[(rl * 4 + k) * 3 + 1];
            TOKO[o] = e; TOKO[131072 + o] = rk; TOKO[3 * 131072 + o] = rec[(rl * 4 + k) * 3 + 2];
            RT2[(size_t)e * RT2_CAP + rk] = (int)(o >> 2);
        }
        __syncthreads();
    }
}
__device__ __forceinline__ void combine_phase(Frame& F, bool last) {
    (void)moe_tables(F, false);
    const LAS int* off = (const LAS int*)(F.lctl + LC_OFF);
    PH_IDS; float* xout = last ? (float*)(__attribute__((address_space(1))) float*)Al->out : WSP(float, WS_XF); const int gw = bid_ * NWAVES + w, NGW = G_ * NWAVES;
    const bf16* X1Bc = WSP(const bf16, WS_Y1); const f32x2* LNS = WSP(const f32x2, WS_LNS); const bf16* Y = WSP(const bf16, WS_PJ); const int* TOK = WSP(const int, WS_TOK); bf16* XB = WSP(bf16, WS_XB); unsigned char* X8 = WSP(unsigned char, WS_X8); (void)X8;
    f32x4 gam[4], bet[4];
#pragma unroll
    for (int j = 0; j < 4; ++j) { gam[j] = *(const f32x4*)(LIN(20, 1024) + 4 * (lane + 64 * j)); bet[j] = *(const f32x4*)(LIN(21, 1024) + 4 * (lane + 64 * j)); }
    f32x4 g1a[4], b1a[4];
#pragma unroll
    for (int j = 0; j < 4; ++j) { g1a[j] = *(const f32x4*)(LIN(12, 1024) + 4 * (lane + 64 * j)) * ALPHA_RES; b1a[j] = *(const f32x4*)(LIN(13, 1024) + 4 * (lane + 64 * j)) * ALPHA_RES; }
#define CB_LOAD(yv, xv, ii) do { const int row_ = gw + (i0 + (ii)) * NGW; if (row_ < M) { \
        _Pragma("unroll") for (int k = 0; k < 4; ++k) { const int slot_ = __builtin_amdgcn_readlane(slot_l, ((ii) & 15) * 4 + k); \
            _Pragma("unroll") for (int j = 0; j < 4; ++j) yv[k][j] = __builtin_nontemporal_load((const GAS v2u*)(Y + (size_t)slot_ * D + 4 * (lane + 64 * j))); } \
        _Pragma("unroll") for (int j = 0; j < 4; ++j) xv[j] = __builtin_nontemporal_load((const GAS v2u*)(X1Bc + (size_t)row_ * D + 4 * (lane + 64 * j))); \
        xv[4] = __builtin_bit_cast(v2u, *(const GAS f32x2*)(LNS + row_)); } } while (0)
#define CB_COMP(yv, xv, ii) do { const int row_ = gw + (i0 + (ii)) * NGW; if (row_ < M) { f32x4 v[4]; \
        const float m1_ = __uint_as_float(xv[4].x), r1_ = __uint_as_float(xv[4].y); \
        _Pragma("unroll") for (int j = 0; j < 4; ++j) v[j] = (((f32x4){bflo(xv[j].x), bfhi(xv[j].x), bflo(xv[j].y), bfhi(xv[j].y)} - m1_) * r1_) * g1a[j] + b1a[j]; \
        _Pragma("unroll") for (int k = 0; k < 4; ++k) { const float gk = __int_as_float(__builtin_amdgcn_readlane(gate_l, ((ii) & 15) * 4 + k)); \
            _Pragma("unroll") for (int j = 0; j < 4; ++j) { v[j][0] = fmaf(gk, bflo(yv[k][j].x), v[j][0]); v[j][1] = fmaf(gk, bfhi(yv[k][j].x), v[j][1]); v[j][2] = fmaf(gk, bflo(yv[k][j].y), v[j][2]); v[j][3] = fmaf(gk, bfhi(yv[k][j].y), v[j][3]); } } \
        float s_ = 0.f; _Pragma("unroll") for (int j = 0; j < 4; ++j) s_ += (v[j][0] + v[j][1]) + (v[j][2] + v[j][3]); \
        const float mean_ = wave_sum(s_) * (1.0f / D); float s2_ = 0.f; \
        _Pragma("unroll") for (int j = 0; j < 4; ++j) { v[j] = v[j] - mean_; s2_ += (v[j][0] * v[j][0] + v[j][1] * v[j][1]) + (v[j][2] * v[j][2] + v[j][3] * v[j][3]); } \
        const float rstd_ = 1.0f / sqrtf(wave_sum(s2_) * (1.0f / D) + LN_EPS); \
        _Pragma("unroll") for (int j = 0; j < 4; ++j) { v[j] = v[j] * rstd_ * gam[j] + bet[j]; \
            if (last) *(GAS f32x4*)(xout + (size_t)row_ * D + 4 * (lane + 64 * j)) = v[j]; \
            else { v2u o_; o_.x = pk2(v[j][0], v[j][1]); o_.y = pk2(v[j][2], v[j][3]); *(GAS v2u*)(XB + (size_t)row_ * D + 4 * (lane + 64 * j)) = o_; \
                if (P1_F8) *(GAS unsigned*)(X8 + (size_t)row_ * D + 4 * (lane + 64 * j)) = pk4_fp8(v[j][0] * SC_X8, v[j][1] * SC_X8, v[j][2] * SC_X8, v[j][3] * SC_X8); } } } } while (0)
    const int nper = (M + NGW - 1) / NGW;
    for (int i0 = 0; i0 < nper; i0 += 16) {
        int slot_l = 0, gate_l = 0;
        { const int rl = gw + (i0 + (lane >> 2)) * NGW;
          if (i0 + (lane >> 2) < nper && rl < M) { const size_t o = (size_t)rl * 4 + (lane & 3); slot_l = off[TOK[o]] + TOK[131072 + o]; gate_l = TOK[3 * 131072 + o]; } }
        v2u yA[4][4], xA[5], yB[4][4], xB[5];
        CB_LOAD(yA, xA, 0);
#pragma unroll 1
        for (int ii = 0; ii < 16; ii += 2) {
            CB_LOAD(yB, xB, ii + 1); CB_COMP(yA, xA, ii);
            if (ii + 2 < 16) CB_LOAD(yA, xA, ii + 2);
            CB_COMP(yB, xB, ii + 1);
        }
    }
#undef CB_LOAD
#undef CB_COMP
}

constexpr int NPHASE = 1 + 10 * DEPTH;
#if ONE_LAUNCH
#ifndef PROBE_BAR
#define PROBE_BAR 0
#endif
#define GRID_BAR() do { xcd_barrier(bar); if (PROBE_BAR) xcd_barrier(bar); } while (0)
#else
#define GRID_BAR() do { } while (0)
#endif
#ifndef STG_P1
#define STG_P1 0
#define STG_P6 0
#define STG_G1 8
#define STG_G2 20
#endif
#define KIND(k) ((k) == 0 ? 0 : (((k) - 1) % 10) + 1)
#define IN(k) (((PHM >> KIND(k)) & 1) && lo <= (k) && (k) < hi)
#define SEAM(k) do { if (IN(k) && IN((k) + 1)) GRID_BAR(); } while (0)
#ifndef PROBE_DBL
#define PROBE_DBL 0
#endif
#define REPS(kind) for (int rep_ = 0; rep_ < (((PROBE_DBL >> (kind)) & 1) ? 2 : 1); ++rep_)
#ifndef PROBE_X1SUB
#define PROBE_X1SUB 0
#endif
#define SUBREP(k) for (int r2_ = 0; r2_ < ((PROBE_X1SUB == (k)) ? 2 : 1); ++r2_)
#if !ONE_LAUNCH
struct XcdBarrierDummy { int x; };
#endif
template <int PHM, int l, class Bar>
__device__ __forceinline__ void layer_phases(Frame& F, Bar& bar, const int lo, const int hi) {
    (void)bar;
        const int pb = 1 + 10 * l;
        F.layer = l;
        if (IN(pb + 0)) {
            REPS(1) {
            PH_PTRS;
#if P1_F8
            {
                pg8::StaticOrder S; S.init(WSP(const bf16, WS_XB), WSP(const bf16, WS_WIN) + (size_t)l * NP * D, M, P1_BF_NT * 256, D, G_, bid_); S.tmap = P1_BF_TM;
#ifdef PROBE_EPI
                EpiProj E{WSP(bf16, WS_PJ), WSP(const f32x2, WS_ROPE), 1.0f, rep_};
#else
                EpiProj E{WSP(bf16, WS_PJ), WSP(const f32x2, WS_ROPE), 1.0f};
#endif
                pg8::gemm_phase<EpiProj, pg8::StaticOrder, true, true, false, STG_P1>(F.lds, D, S, E);
            }
            {
                typedef pg8::SplitOrder<P1_F8_NT, P1_F8_TM, P1_F8_NLO, P1_F8_NHI> SO2; SO2 S2; S2.G = G_; S2.c = bid_; S2.Ab = (const char*)WSP(const unsigned char, WS_X8); S2.Bb = (const char*)(WSP(const unsigned char, WS_WIN8) + (size_t)l * NP * D); S2.tstep = (size_t)256 * D;
#ifdef PROBE_EPI
                EpiProj E2{WSP(bf16, WS_PJ), WSP(const f32x2, WS_ROPE), 1.0f / (SC_X8 * SC_W8), rep_};
#else
                EpiProj E2{WSP(bf16, WS_PJ), WSP(const f32x2, WS_ROPE), 1.0f / (SC_X8 * SC_W8)};
#endif
                pg8::gemm_phase<EpiProj, SO2, true, true, true, 0>(F.lds, D / 2, S2, E2);
            }
#else
            pg8::StaticOrder S; S.init(WSP(const bf16, WS_XB), WSP(const bf16, WS_WIN) + (size_t)l * NP * D, M, NP, D, G_, bid_);
#ifdef PROBE_EPI
            EpiProj E{WSP(bf16, WS_PJ), WSP(const f32x2, WS_ROPE), 1.0f, rep_};
#else
            EpiProj E{WSP(bf16, WS_PJ), WSP(const f32x2, WS_ROPE), 1.0f};
#endif
            pg8::gemm_phase<EpiProj, pg8::StaticOrder, true, true, false, STG_P1>(F.lds, D, S, E);
#endif
            }
            SEAM(pb + 0);
        }
        if (IN(pb + 1)) {
            REPS(2) {
            PH_PTRS;
            constexpr int N_DS = NB * 256, N_RS = NB * 4 * 32, N_RG = NB * 64, N_KM = NB * 16 * 2;
            REPS(12) {
                auto unit_of = [&](int k, int& ub, int& uq) -> bool { const int u = k * G_ + ((k & 1) ? (G_ - 1 - bid_) : bid_); if (u >= N_DS) return false; ub = u & 7; uq = 255 - (u >> 3); return true; };
                int b0 = 0, q0 = 0, k = 0;
                bool have = unit_of(0, b0, q0);
                if (have) { DsaPre p; dsa_pre_issue(F, b0, q0, p); __syncthreads(); dsa_pre_commit(F, p); }
                while (have) {
                    int b1 = 0, q1 = 0; const bool h1 = unit_of(k + 1, b1, q1);
                    dsa_unit(F, b0, q0, h1, b1, q1);
                    b0 = b1; q0 = q1; have = h1; ++k;
                }
            }
            REPS(13) {
              int u = bid_;
              { v4u rk[2], rv[2]; bool pre = false;
                for (; u < N_RS; u += G_) { if (!pre) ret_state_load(F, u >> 7, (u >> 5) & 3, u & 31, rk, rv);
                    const int un = u + G_; const bool hn = un < N_RS;
                    ret_state_unit(F, u >> 7, (u >> 5) & 3, u & 31, rk, rv, hn, un >> 7, (un >> 5) & 3, un & 31); pre = hn; } }
              { RgOps rgo; bool rgp = false;
                for (; u < N_RS + N_RG; u += G_) { const int v = u - N_RS;
                    if (!rgp) rg_raw_load(F, v >> 6, v & 63, rgo);
                    const int un = u + G_; const bool hn = un < N_RS + N_RG; const int vn = un - N_RS;
                    rg_local_unit(F, v >> 6, v & 63, rgo, hn, vn >> 6, vn & 63); rgp = hn; } }
              for (; u < N_RS + N_RG + N_KM; u += G_) { const int v = u - N_RS - N_RG; kmean_unit(F, (v >> 4) & 7, v & 15, v >> 7); }
            }
            }
            SEAM(pb + 1);
        }
        if (IN(pb + 2)) {
            REPS(11) { ret_prefix(F); rg_carry(F); }
            SEAM(pb + 2);
        }
        if (IN(pb + 3)) {
            REPS(4) {
            PH_PTRS;
            const int nround = (1024 + G_ - 1) / G_;
            REPS(14) for (int k = 0; k < nround; ++k) {
                const int u = k * G_ + ((k & 1) ? (G_ - 1 - bid_) : bid_);
                if (u >= 1024) continue;
                const int qt = 15 - (u >> 6), rem = u & 63, b = (rem & 31) >> 2, h = rem & 3;
                if ((rem >> 5) ^ (qt < 8 ? 1 : 0)) attn_unit<1>(F, b, h, qt); else attn_unit<0>(F, b, h, qt);
            }
            REPS(15) for (int u = bid_; u < 512; u += G_) attn_unit<2>(F, u >> 6, (u >> 4) & 3, u & 15);
            REPS(16) for (int u = bid_; u < 512; u += G_) rg_final_unit(F, u >> 6, u & 63);
            }
            SEAM(pb + 3);
        }
        if (IN(pb + 4)) {
            REPS(5) {
            PH_PTRS;
#if P6_F8
            pg8::StaticOrder S; S.init(WSP(const unsigned char, WS_MIX), WSP(const unsigned char, WS_WOUT) + (size_t)l * D * D, M, D, D / 2, G_, bid_);
#else
            pg8::StaticOrder S; S.init(WSP(const bf16, WS_MIX), WSP(const bf16, WS_WOUT) + (size_t)l * D * D, M, D, D, G_, bid_);
#endif
            typedef EpiRes ER;
#ifdef PROBE_EPI
            ER E{WSP(const bf16, WS_XB), WSP(bf16, WS_Y1), rep_};
#else
            ER E{WSP(const bf16, WS_XB), WSP(bf16, WS_Y1)};
#endif
            pg8::gemm_phase<ER, pg8::StaticOrder, true, true, (P6_F8 != 0), STG_P6>(F.lds, P6_F8 ? D / 2 : D, S, E);
            }
            SEAM(pb + 4);
        }
        if (IN(pb + 5)) { if ((PROBE_DBL >> 6) & 1) router_phase(F, true); router_phase(F); if (IN(pb + 7)) GRID_BAR(); }
        if (IN(pb + 7)) {
            REPS(8) {
            const int np = moe_tables(F);
            PH_PTRS;
            pg8::MoeGatherOrder S; S.init(8, np, G_, bid_); S.Ab = (const char*)WSP(const unsigned char, WS_X1Q); S.rowtok = WSP(const int, WS_ROWTOK); S.off = (const LAS int*)(F.lctl + LC_OFF); S.cnt = (const LAS int*)(F.lctl + LC_CNT); S.rowbytes = (unsigned)D; S.Wb = (const char*)(WSP(const unsigned char, WS_W1) + (size_t)l * NE * 2048 * D);
            S.tstep = (size_t)256 * D; S.estride = (size_t)2048 * D; S.ptab = (const LAS int*)(F.lctl + LC_PTAB);
#ifdef PROBE_EPI
            EpiSwiglu E{WSP(unsigned char, WS_G), LIN(17, 65536), (const LAS int*)(F.lctl + LC_PTAB), rep_};
#else
            EpiSwiglu E{WSP(unsigned char, WS_G), LIN(17, 65536), (const LAS int*)(F.lctl + LC_PTAB)};
#endif
            pg8::gemm_phase<EpiSwiglu, pg8::MoeGatherOrder, true, true, true, STG_G1>(F.lds, D / 2, S, E);
            }
            SEAM(pb + 7);
        }
        if (IN(pb + 8)) {
            REPS(9) {
            const int np = moe_tables(F);
            PH_PTRS;
            pg8::MoeOrder S; S.init(4, np, G_, bid_); S.Ab = (const char*)WSP(const unsigned char, WS_G); S.Wb = (const char*)(WSP(const unsigned char, WS_W2) + (size_t)l * NE * D * FF);
            S.tstep = (size_t)256 * FF; S.estride = (size_t)D * FF; S.ptab = (const LAS int*)(F.lctl + LC_PTAB);
#ifdef PROBE_EPI
            EpiBias E{WSP(bf16, WS_PJ), LIN(19, 32768), (const LAS int*)(F.lctl + LC_PTAB), rep_, (bf16*)(wsl + WS_XP + 48 * MiB)};
#else
            EpiBias E{WSP(bf16, WS_PJ), LIN(19, 32768), (const LAS int*)(F.lctl + LC_PTAB)};
#endif
            pg8::gemm_phase<EpiBias, pg8::MoeOrder, true, true, true, STG_G2>(F.lds, FF / 2, S, E);
            }
            SEAM(pb + 8);
        }
        if (IN(pb + 9)) { REPS(10) combine_phase(F, l == DEPTH - 1); SEAM(pb + 9); }
}

template <int PHM> __global__ void __launch_bounds__(NTHR, 2) fwd(Args args) {
    extern __shared__ __attribute__((aligned(16))) unsigned char lds[];
    Frame F;
    F.lds = (LAS unsigned char*)lds; F.lctl = F.lds + LDSCTL_OFF;
    F.G = gridDim.x; F.bid = blockIdx.x; F.ws = args.ws; F.ctl = (gu32*)(args.ws + WS_CTL); F.layer = 0;
    for (int u = threadIdx.x; u < (LDS_BYTES - LDSCTL_OFF) / 4; u += NTHR) ((LAS unsigned*)F.lctl)[u] = 0u;
    __syncthreads();
    const int lo = args.ph_lo, hi = args.ph_hi;
#if ONE_LAUNCH
    XcdBarrier bar = xcd_barrier_post((unsigned*)(F.ctl + CW_BAR), (volatile LAS unsigned*)(F.lctl + LC_MISC));
#else
    XcdBarrierDummy bar{0};
#endif
    if (IN(0)) { REPS(0) p0_prologue(F); SEAM(0); }

    layer_phases<PHM, 0>(F, bar, lo, hi);
    layer_phases<PHM, 1>(F, bar, lo, hi);
    static_assert(DEPTH == 2, "two layer_phases calls");
#undef IN
#undef SEAM
}

typedef void (*KernelFn)(Args);
template <int K> static KernelFn kind_fn() { return fwd<(1 << K)>; }
extern "C" void kernel_launch(void* const* d_in, const int* in_sizes, int n_in, void* d_out, int out_size, void* d_ws, size_t ws_size, hipStream_t stream) {
    static int grid = 0;
#if ONE_LAUNCH
    static KernelFn fns[1] = { fwd<0x7ff> };
    constexpr int NFN = 1;
#else
    static KernelFn fns[11] = { kind_fn<0>(), kind_fn<1>(), kind_fn<2>(), kind_fn<3>(), kind_fn<4>(), kind_fn<5>(), kind_fn<6>(), kind_fn<7>(), kind_fn<8>(), kind_fn<9>(), kind_fn<10>() };
    constexpr int NFN = 11;
#endif
    if (grid == 0) {
        if (n_in != 22 || in_sizes[0] != M * D || out_size != M * D || ws_size < WS_END) {
            fprintf(stderr, "kernel_launch: unexpected shapes (n_in %d, in0 %d, out %d, ws %zu, need %zu); nothing launched\n", n_in, n_in > 0 ? in_sizes[0] : -1, out_size, ws_size, (size_t)WS_END); grid = -1; return; }
        int dev = 0, cus = 0;
        if (hipGetDevice(&dev) != hipSuccess || hipDeviceGetAttribute(&cus, hipDeviceAttributeMultiprocessorCount, dev) != hipSuccess) { fprintf(stderr, "kernel_launch: device query failed\n"); grid = -1; return; }
        for (int i = 0; i < NFN; ++i)
            if (hipFuncSetAttribute((const void*)fns[i], hipFuncAttributeMaxDynamicSharedMemorySize, LDS_BYTES) != hipSuccess) { fprintf(stderr, "kernel_launch: hipFuncSetAttribute failed\n"); grid = -1; return; }
        (void)hipGetLastError();
        grid = cus;
    }
    if (grid < 0) return;
    if (hipMemsetAsync((char*)d_ws + WS_CTL, 0, CTL_ZERO_BYTES, stream) != hipSuccess) { fprintf(stderr, "kernel_launch: memset failed\n"); return; }
    Args a{};
    for (int i = 0; i < 22; ++i) a.in[i] = (const float*)d_in[i];
    a.out = (float*)d_out; a.ws = (unsigned char*)d_ws;
#if ONE_LAUNCH
    a.ph_lo = 0; a.ph_hi = NPHASE;
    hipLaunchKernelGGL(fns[0], dim3(grid), dim3(NTHR), LDS_BYTES, stream, a);
#else
    for (int p = 0; p < NPHASE; ++p) { a.ph_lo = p; a.ph_hi = p + 1; const int kind = (p == 0) ? 0 : ((p - 1) % 10) + 1;
        hipLaunchKernelGGL(fns[kind], dim3(grid), dim3(NTHR), LDS_BYTES, stream, a); }
#endif
}
```
